# Optimizing an MI355X kernel written in HIP

```python
import math
import jax, jax.numpy as jnp
from jax import lax
import numpy as np

D_MODEL = 1024
BATCH = 1
SEQ = 16384
DEPTH = 4

CHUNK = 64
HEAD_DIM = 64
SB_HEADS = D_MODEL // (4 * HEAD_DIM)
CA_HEADS = D_MODEL // (2 * HEAD_DIM)
SB_WIDTH = SB_HEADS * HEAD_DIM
CA_WIDTH = CA_HEADS * HEAD_DIM
SSM_WIDTH = D_MODEL // 4
SSM_GROUP_CH = 16
SSM_GROUPS = SSM_WIDTH // SSM_GROUP_CH
SSM_STATE = 64
D_MIX = SB_WIDTH + CA_WIDTH + SSM_WIDTH
D_IN_PROJ = 3 * SB_WIDTH + 3 * CA_WIDTH + SSM_WIDTH
Q_BLOCK = 128
KSUB = 64
MASK_LOGIT = -1e4
LOOKBACK = 8
BAND = (LOOKBACK + 1) * CHUNK
REL_CLIP = 128
D_FF = ((8 * D_MODEL // 3 + 127) // 128) * 128
N_EXPERTS = 8
TOP_K = 2
MOE_BLOCK = 512
N_DENSE = (DEPTH + 1) // 2
N_MOE = DEPTH // 2
RMS_EPS = 1e-6
DT_MIN = 1e-3
DT_MAX = 1e-1

kernel_name = 'hybrid_sb_chunkattn_s5_moe_trunk'


def rms_norm(x, g):
    xf = x.astype(jnp.float32)
    y = xf * lax.rsqrt(jnp.mean(xf * xf, axis=-1, keepdims=True) + RMS_EPS)
    return (y * g.astype(jnp.float32)).astype(x.dtype)


def stick_breaking_attention(q, k, v):
    b, s, h, dh = q.shape
    nq = s // Q_BLOCK
    scale = 1.0 / math.sqrt(dh)
    qf = q.astype(jnp.float32)
    kf = k.astype(jnp.float32)
    vf = v.astype(jnp.float32)
    sub = jnp.arange(KSUB)
    later_in_sub = (sub[:, None] > sub[None, :]).astype(jnp.float32)
    outs = []
    for i in range(nq):
        nk = (i + 1) * Q_BLOCK
        nsub = nk // KSUB
        z = jnp.einsum('bqhd,bkhd->bhqk', qf[:, i * Q_BLOCK:(i + 1) * Q_BLOCK], kf[:, :nk]) * scale
        q_pos = i * Q_BLOCK + jnp.arange(Q_BLOCK)
        k_pos = jnp.arange(nk)
        z = jnp.where(k_pos[None, :] < q_pos[:, None], z, MASK_LOGIT)
        log_not = jax.nn.log_sigmoid(-z)
        ln = log_not.reshape(b, h, Q_BLOCK, nsub, KSUB)
        within = jnp.einsum('bhqjc,cd->bhqjd', ln, later_in_sub)
        blk = jnp.arange(nsub)
        later_blk = (blk[:, None] > blk[None, :]).astype(jnp.float32)
        across = jnp.einsum('bhqj,jm->bhqm', ln.sum(-1), later_blk)
        after = (within + across[..., None]).reshape(b, h, Q_BLOCK, nk)
        w = jnp.exp(log_not + z + after)
        outs.append(jnp.einsum('bhqk,bkhd->bqhd', w, vf[:, :nk]))
    out = jnp.concatenate(outs, axis=1)
    return out.reshape(b, s, h * dh).astype(q.dtype)


def chunk_band_attention(q, k, v, rel_bias):
    b, s, h, dh = q.shape
    nc = s // CHUNK
    scale = 1.0 / math.sqrt(dh)
    pad = LOOKBACK * CHUNK
    kp = jnp.pad(k, ((0, 0), (pad, 0), (0, 0), (0, 0))).reshape(b, nc + LOOKBACK, CHUNK, h, dh)
    vp = jnp.pad(v, ((0, 0), (pad, 0), (0, 0), (0, 0))).reshape(b, nc + LOOKBACK, CHUNK, h, dh)
    band_idx = jnp.arange(nc)[:, None] + jnp.arange(LOOKBACK + 1)[None, :]
    kb = kp[:, band_idx].reshape(b, nc, BAND, h, dh)
    vb = vp[:, band_idx].reshape(b, nc, BAND, h, dh)
    qc = q.reshape(b, nc, CHUNK, h, dh)
    scores = jnp.einsum('bcqhd,bckhd->bchqk', qc.astype(jnp.float32), kb.astype(jnp.float32)) * scale
    qi = jnp.arange(CHUNK)[:, None]
    kk = jnp.arange(BAND)[None, :]
    dist = LOOKBACK * CHUNK + qi - kk
    bias_idx = jnp.clip(dist, -REL_CLIP, REL_CLIP) + REL_CLIP
    bias = rel_bias.astype(jnp.float32)[:, bias_idx]
    valid = (jnp.arange(nc)[:, None] - LOOKBACK + (jnp.arange(BAND) // CHUNK)[None, :]) >= 0
    scores = jnp.where(valid[None, :, None, None, :], scores + bias[None, None], -1e30)
    p = jax.nn.softmax(scores, axis=-1)
    out = jnp.einsum('bchqk,bckhd->bcqhd', p, vb.astype(jnp.float32))
    return out.reshape(b, s, h * dh).astype(q.dtype)


def _complex_affine_combine(e1, e2):
    a1r, a1i, b1r, b1i = e1
    a2r, a2i, b2r, b2i = e2
    ar = a2r * a1r - a2i * a1i
    ai = a2r * a1i + a2i * a1r
    br = a2r * b1r - a2i * b1i + b2r
    bi = a2r * b1i + a2i * b1r + b2i
    return (ar, ai, br, bi)


def s5_mixer(u, lam_re, lam_im, log_dt, b_re, b_im, c_re, c_im, d_skip, w_glu):
    bsz, s, w = u.shape
    uf = u.astype(jnp.float32)
    ug = uf.reshape(bsz, s, SSM_GROUPS, SSM_GROUP_CH)
    dt = jnp.exp(log_dt.astype(jnp.float32))[:, None]
    lre = lam_re.astype(jnp.float32)
    lim = lam_im.astype(jnp.float32)
    mag = jnp.exp(lre * dt)
    ang = lim * dt
    abar_re = mag * jnp.cos(ang)
    abar_im = mag * jnp.sin(ang)
    nre = abar_re - 1.0
    nim = abar_im
    den = lre * lre + lim * lim
    zoh_re = ((nre * lre + nim * lim) / den)[..., None]
    zoh_im = ((nim * lre - nre * lim) / den)[..., None]
    bre = b_re.astype(jnp.float32)
    bim = b_im.astype(jnp.float32)
    bbar_re = zoh_re * bre - zoh_im * bim
    bbar_im = zoh_re * bim + zoh_im * bre
    bu_re = jnp.einsum('gpc,bsgc->bsgp', bbar_re, ug)
    bu_im = jnp.einsum('gpc,bsgc->bsgp', bbar_im, ug)
    a_re = jnp.broadcast_to(abar_re, bu_re.shape)
    a_im = jnp.broadcast_to(abar_im, bu_im.shape)
    _, _, x_re, x_im = lax.associative_scan(_complex_affine_combine, (a_re, a_im, bu_re, bu_im), axis=1)
    y = (jnp.einsum('gcp,bsgp->bsgc', c_re.astype(jnp.float32), x_re)
         - jnp.einsum('gcp,bsgp->bsgc', c_im.astype(jnp.float32), x_im))
    y = y.reshape(bsz, s, w) + d_skip.astype(jnp.float32) * uf
    y = jax.nn.gelu(y)
    hg = jnp.einsum('bsc,ce->bse', y, w_glu.astype(jnp.float32))
    out = hg[..., :w] * jax.nn.sigmoid(hg[..., w:])
    return out.astype(u.dtype)


def swiglu(x, w_gate, w_up, w_down):
    hid = jax.nn.silu(x @ w_gate) * (x @ w_up)
    return hid @ w_down


def moe_swiglu(xn, w_router, w_gate, w_up, w_down):
    b, s, d = xn.shape
    t = b * s
    xf = xn.reshape(t, d)
    logits = jnp.einsum('td,de->te', xf.astype(jnp.float32), w_router.astype(jnp.float32))
    top_vals, top_idx = lax.top_k(logits, TOP_K)
    gates = jax.nn.softmax(top_vals, axis=-1)
    flat_e = top_idx.reshape(-1)
    flat_tok = jnp.repeat(jnp.arange(t, dtype=jnp.int32), TOP_K)
    flat_g = gates.reshape(-1)
    order = jnp.argsort(flat_e)
    se = flat_e[order]
    stok = flat_tok[order]
    sg = flat_g[order]
    counts = jnp.bincount(flat_e, length=N_EXPERTS)
    padded = (counts + MOE_BLOCK - 1) // MOE_BLOCK * MOE_BLOCK
    pend = jnp.cumsum(padded)
    pstart = pend - padded
    ustart = jnp.cumsum(counts) - counts
    pos = pstart[se] + (jnp.arange(t * TOP_K) - ustart[se])
    n_blocks = -(-(t * TOP_K) // MOE_BLOCK) + N_EXPERTS
    n_slots = n_blocks * MOE_BLOCK
    slot_tok = jnp.full((n_slots,), t, dtype=jnp.int32).at[pos].set(stok)
    slot_gate = jnp.zeros((n_slots,), jnp.float32).at[pos].set(sg)
    block_e = jnp.minimum(jnp.searchsorted(pend, jnp.arange(n_blocks) * MOE_BLOCK, side='right'), N_EXPERTS - 1)
    xpad = jnp.concatenate([xf, jnp.zeros((1, d), xf.dtype)], axis=0)

    def block_fn(args):
        tok, g, e = args
        xb = xpad[tok]
        yb = swiglu(xb, w_gate[e], w_up[e], w_down[e])
        return yb * g.astype(yb.dtype)[:, None]

    ys = lax.map(block_fn, (slot_tok.reshape(n_blocks, MOE_BLOCK), slot_gate.reshape(n_blocks, MOE_BLOCK), block_e))
    out = jnp.zeros((t + 1, d), ys.dtype).at[slot_tok].add(ys.reshape(n_slots, d))[:t]
    return out.reshape(b, s, d).astype(xn.dtype)


def setup_inputs(seed: int = 0) -> dict:
    key = jax.random.key(seed)
    ks = jax.random.split(key, 32)

    def nrm(k, shape, scale):
        return jax.random.normal(k, shape, jnp.float32) * scale

    def gain(k, shape):
        return 1.0 + 0.05 * jax.random.normal(k, shape, jnp.float32)

    n_idx = jnp.arange(SSM_STATE, dtype=jnp.float32)
    return {
        'x': nrm(ks[0], (BATCH, SEQ, D_MODEL), 1.0),
        'norm_mix': gain(ks[1], (DEPTH, D_MODEL)),
        'w_in': nrm(ks[2], (DEPTH, D_MODEL, D_IN_PROJ), D_MODEL ** -0.5),
        'q_norm_sb': gain(ks[3], (DEPTH, HEAD_DIM)),
        'k_norm_sb': gain(ks[4], (DEPTH, HEAD_DIM)),
        'q_norm_ca': gain(ks[5], (DEPTH, HEAD_DIM)),
        'k_norm_ca': gain(ks[6], (DEPTH, HEAD_DIM)),
        'rel_bias': nrm(ks[7], (DEPTH, CA_HEADS, 2 * REL_CLIP + 1), 0.3),
        'lam_re': -0.5 + nrm(ks[8], (DEPTH, SSM_GROUPS, SSM_STATE), 0.01),
        'lam_im': math.pi * n_idx + nrm(ks[9], (DEPTH, SSM_GROUPS, SSM_STATE), 0.01),
        'log_dt': jax.random.uniform(ks[10], (DEPTH, SSM_GROUPS), jnp.float32, math.log(DT_MIN), math.log(DT_MAX)),
        'b_re': nrm(ks[11], (DEPTH, SSM_GROUPS, SSM_STATE, SSM_GROUP_CH), (2 * SSM_GROUP_CH) ** -0.5),
        'b_im': nrm(ks[12], (DEPTH, SSM_GROUPS, SSM_STATE, SSM_GROUP_CH), (2 * SSM_GROUP_CH) ** -0.5),
        'c_re': nrm(ks[13], (DEPTH, SSM_GROUPS, SSM_GROUP_CH, SSM_STATE), SSM_STATE ** -0.5),
        'c_im': nrm(ks[14], (DEPTH, SSM_GROUPS, SSM_GROUP_CH, SSM_STATE), SSM_STATE ** -0.5),
        'd_skip': nrm(ks[15], (DEPTH, SSM_WIDTH), 0.5),
        'w_glu': nrm(ks[16], (DEPTH, SSM_WIDTH, 2 * SSM_WIDTH), SSM_WIDTH ** -0.5),
        'g_out': gain(ks[17], (DEPTH, D_MIX)),
        'w_out': nrm(ks[18], (DEPTH, D_MIX, D_MODEL), 0.5 * D_MIX ** -0.5),
        'norm_ffn': gain(ks[19], (DEPTH, D_MODEL)),
        'w_gate_dense': nrm(ks[20], (N_DENSE, D_MODEL, D_FF), D_MODEL ** -0.5),
        'w_up_dense': nrm(ks[21], (N_DENSE, D_MODEL, D_FF), D_MODEL ** -0.5),
        'w_down_dense': nrm(ks[22], (N_DENSE, D_FF, D_MODEL), 0.5 * D_FF ** -0.5),
        'w_router': nrm(ks[23], (N_MOE, D_MODEL, N_EXPERTS), D_MODEL ** -0.5),
        'w_gate_moe': nrm(ks[24], (N_MOE, N_EXPERTS, D_MODEL, D_FF), D_MODEL ** -0.5),
        'w_up_moe': nrm(ks[25], (N_MOE, N_EXPERTS, D_MODEL, D_FF), D_MODEL ** -0.5),
        'w_down_moe': nrm(ks[26], (N_MOE, N_EXPERTS, D_FF, D_MODEL), 0.5 * D_FF ** -0.5),
    }


def reference(x, norm_mix, w_in, q_norm_sb, k_norm_sb, q_norm_ca, k_norm_ca, rel_bias,
              lam_re, lam_im, log_dt, b_re, b_im, c_re, c_im, d_skip, w_glu, g_out, w_out,
              norm_ffn, w_gate_dense, w_up_dense, w_down_dense, w_router, w_gate_moe,
              w_up_moe, w_down_moe):
    b, s, _ = x.shape
    o1 = SB_WIDTH
    o2 = 2 * SB_WIDTH
    o3 = 3 * SB_WIDTH
    o4 = o3 + CA_WIDTH
    o5 = o4 + CA_WIDTH
    o6 = o5 + CA_WIDTH
    for l in range(DEPTH):
        h = rms_norm(x, norm_mix[l])
        proj = jnp.einsum('bsd,de->bse', h, w_in[l])
        q_sb = rms_norm(proj[..., :o1].reshape(b, s, SB_HEADS, HEAD_DIM), q_norm_sb[l])
        k_sb = rms_norm(proj[..., o1:o2].reshape(b, s, SB_HEADS, HEAD_DIM), k_norm_sb[l])
        v_sb = proj[..., o2:o3].reshape(b, s, SB_HEADS, HEAD_DIM)
        q_ca = rms_norm(proj[..., o3:o4].reshape(b, s, CA_HEADS, HEAD_DIM), q_norm_ca[l])
        k_ca = rms_norm(proj[..., o4:o5].reshape(b, s, CA_HEADS, HEAD_DIM), k_norm_ca[l])
        v_ca = proj[..., o5:o6].reshape(b, s, CA_HEADS, HEAD_DIM)
        u = proj[..., o6:]
        o_sb = stick_breaking_attention(q_sb, k_sb, v_sb)
        o_ca = chunk_band_attention(q_ca, k_ca, v_ca, rel_bias[l])
        o_ssm = s5_mixer(u, lam_re[l], lam_im[l], log_dt[l], b_re[l], b_im[l], c_re[l], c_im[l], d_skip[l], w_glu[l])
        g = g_out[l]
        mixed = jnp.concatenate([
            rms_norm(o_sb, g[:SB_WIDTH]),
            rms_norm(o_ca, g[SB_WIDTH:SB_WIDTH + CA_WIDTH]),
            rms_norm(o_ssm, g[SB_WIDTH + CA_WIDTH:]),
        ], axis=-1)
        x = x + jnp.einsum('bse,ed->bsd', mixed, w_out[l])
        h2 = rms_norm(x, norm_ffn[l])
        i = l // 2
        if l % 2 == 0:
            x = x + swiglu(h2, w_gate_dense[i], w_up_dense[i], w_down_dense[i])
        else:
            x = x + moe_swiglu(h2, w_router[i], w_gate_moe[i], w_up_moe[i], w_down_moe[i])
    return x
```

```cpp
#include <hip/hip_runtime.h>
#include <cstdio>
#include <cstdint>
namespace pg8 {
#define PG8_LAS __attribute__((address_space(3)))
typedef unsigned short bf16_t;
typedef short bf16x8 __attribute__((ext_vector_type(8)));
typedef float f32x4 __attribute__((ext_vector_type(4)));
typedef unsigned u32x4 __attribute__((ext_vector_type(4)));
constexpr int BM = 256, BK = 64, HALF = 128, HTB = HALF * BK * 2  , STAGE_BYTES = 8 * HTB, NXCD = 8, WGM_DEFAULT = 4;

__host__ __device__ __forceinline__ int lds_byte(int r, int c) { const int st = (r >> 4) * 2 + (c >> 5), rr = r & 15, cc = c & 31, ob = rr * 64 + cc * 2; return st * 1024 + (ob ^ (((ob >> 9) & 1) << 5)); }
__host__ __device__ __forceinline__ void stage_rc(int b, int& R, int& C) { const int st = b / 1024, sb = b % 1024, swz = sb ^ (((sb >> 9) & 1) << 5); R = (st >> 1) * 16 + swz / 64; C = (st & 1) * 32 + (swz % 64) / 2; }
__host__ __device__ __forceinline__ int perm32(int rho) { const int n = rho >> 4, i = rho & 15; return 8 * (i >> 2) + 4 * n + (i & 3); }

struct Unit { int pm, pn, half, ord; };
struct Gemm { const bf16_t* A; const bf16_t* Bt; int M, N, K; const int* tile_e; size_t estride; int tid; int Klen; const int* gidx; };

struct StaticOrder {
    int nM, nN, nwg, G, c, limit, WGM;
    __host__ __device__ void init(int M, int N, int G_, int c_, int wgm = WGM_DEFAULT) { nM = M / BM; nN = N / BM; nwg = nM * nN; G = G_; c = c_; limit = nwg; WGM = wgm; }
    __host__ __device__ bool next(int i, Unit& u) const {
        const long L = (long)i * G + c; if (L >= limit) return false; u.half = 0; u.ord = i;
        int wgid = (int)L; { const int q = nwg / NXCD, r = nwg % NXCD, xcd = wgid % NXCD, off = wgid / NXCD; wgid = (xcd < r ? xcd * (q + 1) : r * (q + 1) + (xcd - r) * q) + off; }
        const int nig = WGM * nN, gid = wgid / nig, fm = gid * WGM, gsz = (nM - fm) < WGM ? (nM - fm) : WGM;
        u.pm = fm + ((wgid % nig) % gsz); u.pn = (wgid % nig) / gsz; return true;
    }
    __device__ __forceinline__ bool first_unit(Unit& u) const {
        if (c >= nwg) return false; u.half = 0; u.ord = 0;
        int wgid = c; { const int q = nwg / NXCD, r = nwg % NXCD, xcd = wgid % NXCD, off = wgid / NXCD; wgid = (xcd < r ? xcd * (q + 1) : r * (q + 1) + (xcd - r) * q) + off; }
        const int nig = WGM * nN, gid = wgid / nig, fm = gid * WGM, gsz = (nM - fm) < WGM ? (nM - fm) : WGM;
        u.pm = fm + ((wgid % nig) % gsz); u.pn = (wgid % nig) / gsz; return true;
    }
    __device__ __forceinline__ void a_ready(const Unit&) const {}
    __device__ __forceinline__ void done(const Unit&) const {}
    __host__ __device__ __forceinline__ void unit_of(int L, Unit& u) const {
        int wgid = L; { const int q = nwg / NXCD, r = nwg % NXCD, xcd = wgid % NXCD, off = wgid / NXCD; wgid = (xcd < r ? xcd * (q + 1) : r * (q + 1) + (xcd - r) * q) + off; }
        const int nig = WGM * nN, gid = wgid / nig, fm = gid * WGM, gsz = (nM - fm) < WGM ? (nM - fm) : WGM;
        u.pm = fm + ((wgid % nig) % gsz); u.pn = (wgid % nig) / gsz;
    }
};
struct LeftoverOrder {
    StaticOrder so; int base;
    __host__ __device__ void init(int M, int N, int G_, int c_, int base_, int wgm = WGM_DEFAULT) { so.init(M, N, G_, c_, wgm); base = base_; }
    __host__ __device__ bool next(int i, Unit& u) const {
        const int j = i * so.G + so.c; if (j >= 2 * (so.nwg - base)) return false;
        so.unit_of(base + (j >> 1), u); u.half = j & 1; u.ord = i; return true;
    }
    __device__ __forceinline__ void a_ready(const Unit&) const {}
    __device__ __forceinline__ void done(const Unit&) const {}
};

__device__ __forceinline__ unsigned cvt_pk_bf16(float lo, float hi) { unsigned r; asm volatile("v_cvt_pk_bf16_f32 %0, %1, %2" : "=v"(r) : "v"(lo), "v"(hi)); return r; }
__device__ __forceinline__ u32x4 pack8(const f32x4& a, const f32x4& b) { u32x4 w; w.x = cvt_pk_bf16(a[0], a[1]); w.y = cvt_pk_bf16(a[2], a[3]); w.z = cvt_pk_bf16(b[0], b[1]); w.w = cvt_pk_bf16(b[2], b[3]); return w; }

__device__ __forceinline__ float sum4f(const float* p) { const f32x4 a = *(const f32x4*)p; return (a[0] + a[1]) + (a[2] + a[3]); }
__device__ __forceinline__ float sum8f(const float* p) { return sum4f(p) + sum4f(p + 4); }
__device__ __forceinline__ float sum16f(const float* p) { return sum8f(p) + sum8f(p + 8); }
__device__ __forceinline__ float row_sum16(const float* base16, int fq) { float s = sum4f(base16 + 4 * fq); s += __shfl_xor(s, 16); s += __shfl_xor(s, 32); return s; }
__device__ __forceinline__ void rows_rstd16(float (&r)[2][4], const float* ss16, int row0  , int fq) {
    f32x4 pv[2][4];
#pragma unroll
    for (int ai = 0; ai < 2; ++ai)
#pragma unroll
        for (int m = 0; m < 4; ++m) pv[ai][m] = *(const f32x4*)(ss16 + (size_t)(row0 + ai * HALF + m * 16) * 16 + 4 * fq);
#pragma unroll
    for (int ai = 0; ai < 2; ++ai)
#pragma unroll
        for (int m = 0; m < 4; ++m) { float s = (pv[ai][m][0] + pv[ai][m][1]) + (pv[ai][m][2] + pv[ai][m][3]); s += __shfl_xor(s, 16); s += __shfl_xor(s, 32); r[ai][m] = rsqrtf(s * (1.f / 1024.f) + 1e-6f); }
}
struct EpiInProj {
    static constexpr bool PERM = true, AFTER_DRAIN = false;
    static constexpr bool KHOOK = false, GATHER = false;
    bf16_t* P; const float *gq_sb, *gk_sb, *gq_ca, *gk_ca; float qscale; const PG8_LAS float* rs_lds; int ppitch;
    __device__ __forceinline__ void operator()(const f32x4 (&acc)[2][2][4][2], const Unit& u, int wr, int wc, int fr, int fq) const {
        const int pn = u.pn; const float* g = nullptr; float gs = 1.f;
        if (pn == 0) { g = gq_sb; gs = qscale; } else if (pn == 1) { g = gk_sb; } else if (pn == 3 || pn == 4) { g = gq_ca; gs = qscale; } else if (pn == 5 || pn == 6) { g = gk_ca; }
        bf16_t* base = P + (size_t)(u.pm * BM + wr * 64 + fr) * ppitch + pn * 256 + wc * 64 + fq * 8;
        float r0s[2][4];
#pragma unroll
        for (int ai = 0; ai < 2; ++ai)
#pragma unroll
            for (int m = 0; m < 4; ++m) r0s[ai][m] = rs_lds[u.ord * 256 + ai * HALF + wr * 64 + m * 16 + fr];
        if (g) {
            f32x4 gv[2][2];
#pragma unroll
            for (int bj = 0; bj < 2; ++bj)
#pragma unroll
                for (int n = 0; n < 2; ++n) gv[bj][n] = *(const f32x4*)(g + 32 * bj + 8 * fq + 4 * n) * gs;
#pragma unroll
            for (int ai = 0; ai < 2; ++ai)
#pragma unroll
                for (int m = 0; m < 4; ++m) {
                    const float r0 = r0s[ai][m];
                    float ss = 0.f;
#pragma unroll
                    for (int bj = 0; bj < 2; ++bj)
#pragma unroll
                        for (int n = 0; n < 2; ++n) { const f32x4 v = acc[ai][bj][m][n]; ss += v[0] * v[0] + v[1] * v[1] + v[2] * v[2] + v[3] * v[3]; }
                    ss += __shfl_xor(ss, 16); ss += __shfl_xor(ss, 32);
                    const float r = r0 * rsqrtf(ss * (r0 * r0) * (1.f / 64.f) + 1e-6f);
                    bf16_t* rowp = base + (size_t)(ai * HALF + m * 16) * ppitch;
#pragma unroll
                    for (int bj = 0; bj < 2; ++bj) *(u32x4*)(rowp + bj * 32) = pack8(acc[ai][bj][m][0] * r * gv[bj][0], acc[ai][bj][m][1] * r * gv[bj][1]);
                }
        } else {
#pragma unroll
            for (int ai = 0; ai < 2; ++ai)
#pragma unroll
                for (int m = 0; m < 4; ++m) { bf16_t* rowp = base + (size_t)(ai * HALF + m * 16) * ppitch;
                    const float r0 = r0s[ai][m];
#pragma unroll
                    for (int bj = 0; bj < 2; ++bj) *(u32x4*)(rowp + bj * 32) = pack8(acc[ai][bj][m][0] * r0, acc[ai][bj][m][1] * r0); }
        }
    }
};
template <int KIND, int RSMODE = 0> struct EpiGated {
    static constexpr bool PERM = true, AFTER_DRAIN = false, KHOOK = false, GATHER = (KIND == 1 && RSMODE == 1);
    bf16_t* O; int ldc; int col0; const float* rs; float* ssq; const PG8_LAS float* rs_lds;
    __device__ __forceinline__ void operator()(const f32x4 (&acc)[2][2][4][2], const Unit& u, int wr, int wc, int fr, int fq) const {
        float rrs[2][4];
        if (KIND == 1) { if (RSMODE == 0) rows_rstd16(rrs, rs, u.pm * BM + wr * 64 + fr, fq); else if (RSMODE == 2) {
#pragma unroll
            for (int ai = 0; ai < 2; ++ai)
#pragma unroll
                for (int m = 0; m < 4; ++m) rrs[ai][m] = rs_lds[u.ord * 256 + ai * HALF + wr * 64 + m * 16 + fr]; } else {
#pragma unroll
            for (int ai = 0; ai < 2; ++ai)
#pragma unroll
                for (int m = 0; m < 4; ++m) rrs[ai][m] = rs[u.pm * BM + ai * HALF + wr * 64 + m * 16 + fr]; } }
#pragma unroll
        for (int ai = 0; ai < 2; ++ai)
#pragma unroll
            for (int m = 0; m < 4; ++m) {
                const int row = u.pm * BM + ai * HALF + wr * 64 + m * 16 + fr;
                float rr = 1.f;
                if (KIND == 1) rr = rrs[ai][m];
                f32x4 r[2]; float sq = 0.f;
#pragma unroll
                for (int n = 0; n < 2; ++n)
#pragma unroll
                    for (int e = 0; e < 4; ++e) { const float a = acc[ai][0][m][n][e] * rr, b = acc[ai][1][m][n][e] * rr;
                        const float o = (KIND == 0) ? a * __builtin_amdgcn_rcpf(1.f + __expf(-b)) : a * __builtin_amdgcn_rcpf(1.f + __expf(-a)) * b; r[n][e] = o; sq += o * o; }
                *(u32x4*)(O + (size_t)row * ldc + col0 + u.pn * 128 + wc * 32 + fq * 8) = pack8(r[0], r[1]);
                if (KIND == 0) { sq += __shfl_xor(sq, 16); sq += __shfl_xor(sq, 32); if (fq == 0) ssq[(size_t)row * 8 + u.pn * 4 + wc] = sq; }
            }
    }
};
template <bool HOOKED> struct EpiResidual {
    static constexpr bool PERM = true, AFTER_DRAIN = false, KHOOK = HOOKED, GATHER = false;
    float* X; const float* Xsrc; int ldc; float scale; bf16_t* XB; float* ss_out; const PG8_LAS float* fac;
    __device__ __forceinline__ void khook(int t, f32x4 (&acc)[2][2][4][2], const Unit& u, int wr, int fr) const {
        if (t != 4 && t != 8) return;
        const PG8_LAS float* fp = fac + (t == 4 ? 0 : 256) + wr * 64 + fr;
#pragma unroll
        for (int ai = 0; ai < 2; ++ai)
#pragma unroll
            for (int m = 0; m < 4; ++m) {
                const float f = fp[ai * HALF + m * 16];
#pragma unroll
                for (int bj = 0; bj < 2; ++bj)
#pragma unroll
                    for (int n = 0; n < 2; ++n) acc[ai][bj][m][n] = acc[ai][bj][m][n] * f;
            }
    }
    __device__ __forceinline__ void operator()(const f32x4 (&acc)[2][2][4][2], const Unit& u, int wr, int wc, int fr, int fq) const {
#pragma unroll
        for (int ai = 0; ai < 2; ++ai)
#pragma unroll
            for (int m = 0; m < 4; ++m) {
                const int row = u.pm * BM + ai * HALF + wr * 64 + m * 16 + fr;
                float sc = scale; if (HOOKED) sc *= fac[512 + ai * HALF + wr * 64 + m * 16 + fr];
                float sq = 0.f;
#pragma unroll
                for (int bj = 0; bj < 2; ++bj) { const size_t off = (size_t)row * ldc + u.pn * BM + bj * HALF + wc * 32 + fq * 8; f32x4* p = (f32x4*)(X + off); const f32x4* ps = (const f32x4*)(Xsrc + off);
                    const f32x4 a = ps[0] + acc[ai][bj][m][0] * sc, b = ps[1] + acc[ai][bj][m][1] * sc; p[0] = a; p[1] = b;
                    *(u32x4*)(XB + off) = pack8(a, b);
                    sq += a[0] * a[0] + a[1] * a[1] + a[2] * a[2] + a[3] * a[3] + b[0] * b[0] + b[1] * b[1] + b[2] * b[2] + b[3] * b[3]; }
                sq += __shfl_xor(sq, 16); sq += __shfl_xor(sq, 32);
                if (fq == 0) ss_out[(size_t)row * 16 + u.pn * 4 + wc] = sq;
            }
    }
};
struct EpiStoreBf16 {
    static constexpr bool PERM = true, AFTER_DRAIN = false, KHOOK = false, GATHER = false;
    bf16_t* O; int ldc; bf16_t* O2;
    __device__ __forceinline__ void operator()(const f32x4 (&acc)[2][2][4][2], const Unit& u, int wr, int wc, int fr, int fq) const {
        bf16_t* Ob = u.half ? O2 : O;
#pragma unroll
        for (int ai = 0; ai < 2; ++ai)
#pragma unroll
            for (int m = 0; m < 4; ++m) {
                const int row = u.pm * BM + ai * HALF + wr * 64 + m * 16 + fr;
#pragma unroll
                for (int bj = 0; bj < 2; ++bj) *(u32x4*)(Ob + (size_t)row * ldc + u.pn * BM + bj * HALF + wc * 32 + fq * 8) = pack8(acc[ai][bj][m][0], acc[ai][bj][m][1]);
            }
    }
};
template <class Epi, class Sched, bool ALIGN_EPI = false, bool SP2 = false>
__device__ __forceinline__ void gemm_phase(PG8_LAS unsigned char* lds, const Gemm g, const Sched& S, const Epi& E) {
    int tid_ = g.tid; asm volatile("" : "+v"(tid_));
    const int tid = tid_, wid = __builtin_amdgcn_readfirstlane(tid >> 6), lane = tid & 63, wr = wid >> 2, wc = wid & 3, fr = lane & 15, fq = lane >> 4;
    const int K = g.K, klen = g.Klen ? g.Klen : g.K, nt = klen / BK;
    const size_t hoff = (size_t)klen * 2;
    unsigned voffA[2], voffB[2];
#pragma unroll
    for (int i = 0; i < 2; ++i) { int R, C; stage_rc(tid * 16 + i * 8192, R, C); const int Rb = Epi::PERM ? ((R & ~31) + perm32(R & 31)) : R;
        voffA[i] = (unsigned)(R * K + C) * 2u; voffB[i] = (unsigned)(Rb * K + C) * 2u; }
    constexpr bool GA = Epi::GATHER; static_assert(!GA || SP2, "gather is wired into the SP2 loop only");
    unsigned vc0[2] = {0u, 0u}, vc1[2] = {0u, 0u}, vn0[2] = {0u, 0u}, vn1[2] = {0u, 0u};
#define PG8_GOFF(d0, d1, pm_) do { _Pragma("unroll") for (int _i = 0; _i < 2; ++_i) { int R_, C_; stage_rc(tid * 16 + _i * 8192, R_, C_); const int* gp_ = g.gidx + (pm_) * 256 + R_; \
        d0[_i] = ((unsigned)gp_[0] * (unsigned)K + (unsigned)C_) * 2u; d1[_i] = ((unsigned)gp_[HALF] * (unsigned)K + (unsigned)C_) * 2u; } } while (0)
    const size_t kstep = (size_t)(BK * 2);
    const size_t hstep = (size_t)HALF * K * 2;
    const size_t tstep = 2 * hstep;
    const unsigned ldsw = (unsigned)wid * 1024u;
    const int aoff = lds_byte(wr * 64 + fr, fq * 8), boff = lds_byte(wc * 32 + fr, fq * 8);
#define PG8_SA(b, h) (((b) * 2 + (h)) * HTB)
#define PG8_SB(b, h) ((4 + (b) * 2 + (h)) * HTB)
#define PG8_STAGE(bufoff, gbase, voff) do { _Pragma("unroll") for (int _i = 0; _i < 2; ++_i) \
        __builtin_amdgcn_global_load_lds((const unsigned*)((const char*)(gbase) + (voff)[_i]), (PG8_LAS unsigned*)(lds + (bufoff) + ldsw + _i * 8192), 16, 0, 0); } while (0)
#define PG8_LDA(dst, b, h) do { _Pragma("unroll") for (int m = 0; m < 4; ++m) _Pragma("unroll") for (int k = 0; k < 2; ++k) dst[m][k] = *(const PG8_LAS bf16x8*)(lds + PG8_SA(b, h) + aoff + m * 2048 + k * 1024); } while (0)
#define PG8_LDB(dst, b, h) do { _Pragma("unroll") for (int n = 0; n < 2; ++n) _Pragma("unroll") for (int k = 0; k < 2; ++k) dst[n][k] = *(const PG8_LAS bf16x8*)(lds + PG8_SB(b, h) + boff + n * 2048 + k * 1024); } while (0)
#define PG8_MMA(ai, bj, At, Bt) do { __builtin_amdgcn_s_setprio(1); _Pragma("unroll") for (int m = 0; m < 4; ++m) _Pragma("unroll") for (int n = 0; n < 2; ++n) _Pragma("unroll") for (int k = 0; k < 2; ++k) \
        acc[ai][bj][m][n] = __builtin_amdgcn_mfma_f32_16x16x32_bf16(Bt[n][k], At[m][k], acc[ai][bj][m][n], 0, 0, 0); __builtin_amdgcn_s_setprio(0); } while (0)
#define PG8_WAIT_V(n) asm volatile("s_waitcnt vmcnt(" #n ")" ::: "memory")
#define PG8_WAIT_L(n) asm volatile("s_waitcnt lgkmcnt(" #n ")" ::: "memory")
#define PG8_BAR __builtin_amdgcn_s_barrier()
#define PG8_SCHED __builtin_amdgcn_sched_barrier(0)
    Unit cur, nxt; int ui = 0;
    if (!S.next(0, cur)) return;
    f32x4 acc[2][2][4][2];
#pragma unroll
    for (int a = 0; a < 2; ++a)
#pragma unroll
        for (int b = 0; b < 2; ++b)
#pragma unroll
            for (int m = 0; m < 4; ++m)
#pragma unroll
                for (int n = 0; n < 2; ++n) acc[a][b][m][n] = (f32x4){0.f, 0.f, 0.f, 0.f};
    bf16x8 At[4][2], B0[2][2], B1[2][2];
    const char* cA = (const char*)g.A + (GA ? (size_t)0 : (size_t)cur.pm * tstep) + cur.half * hoff;
    if constexpr (GA) PG8_GOFF(vc0, vc1, cur.pm);
    const char* cB = (const char*)g.Bt + (g.tile_e ? (size_t)g.tile_e[cur.pm] * g.estride : (size_t)0) + (size_t)cur.pn * tstep + cur.half * hoff;
    S.a_ready(cur);
    if constexpr (SP2) {
        PG8_STAGE(PG8_SB(0, 0), cB, voffB); PG8_STAGE(PG8_SB(0, 1), cB + hstep, voffB);
        if constexpr (GA) { PG8_STAGE(PG8_SA(0, 0), cA, vc0); PG8_STAGE(PG8_SA(0, 1), cA, vc1); } else { PG8_STAGE(PG8_SA(0, 0), cA, voffA); PG8_STAGE(PG8_SA(0, 1), cA + hstep, voffA); }
        if (wr == 1) PG8_BAR;
        PG8_WAIT_V(2); PG8_BAR;
        PG8_STAGE(PG8_SB(1, 0), cB + kstep, voffB); if constexpr (GA) PG8_STAGE(PG8_SA(1, 0), cA + kstep, vc0); else PG8_STAGE(PG8_SA(1, 0), cA + kstep, voffA); PG8_STAGE(PG8_SB(1, 1), cB + hstep + kstep, voffB);
        PG8_WAIT_V(6); PG8_BAR;
    } else {
        PG8_STAGE(PG8_SB(0, 0), cB, voffB); PG8_STAGE(PG8_SA(0, 0), cA, voffA); PG8_STAGE(PG8_SB(0, 1), cB + hstep, voffB); PG8_STAGE(PG8_SA(0, 1), cA + hstep, voffA);
        if (wr == 1) PG8_BAR;
        PG8_WAIT_V(4); PG8_BAR;
        PG8_STAGE(PG8_SB(1, 0), cB + kstep, voffB); PG8_STAGE(PG8_SA(1, 0), cA + kstep, voffA); PG8_STAGE(PG8_SB(1, 1), cB + hstep + kstep, voffB);
        PG8_WAIT_V(6); PG8_BAR;
    }
    for (;;) {
        const bool has_next = S.next(ui + 1, nxt);
        if constexpr (GA) { if (has_next) PG8_GOFF(vn0, vn1, nxt.pm); else { vn0[0] = vc0[0]; vn0[1] = vc0[1]; vn1[0] = vc1[0]; vn1[1] = vc1[1]; } }
        const char* nA = has_next ? (const char*)g.A + (GA ? (size_t)0 : (size_t)nxt.pm * tstep) + nxt.half * hoff : cA; const char* nB = has_next ? (const char*)g.Bt + (g.tile_e ? (size_t)g.tile_e[nxt.pm] * g.estride : (size_t)0) + (size_t)nxt.pn * tstep + nxt.half * hoff : cB;
        for (int t = 0; t < nt; t += 2) {
            if constexpr (Epi::KHOOK) E.khook(t, acc, cur, wr, fr);
            const bool last = (t == nt - 2);
            const char* a1 = cA + (size_t)(t + 1) * kstep;
            const char* a2 = last ? nA : cA + (size_t)(t + 2) * kstep; const char* b2 = last ? nB : cB + (size_t)(t + 2) * kstep;
            const char* a3 = a2 + kstep; const char* b3 = b2 + kstep;
            if (last && has_next) S.a_ready(nxt);
            if constexpr (SP2) {
            unsigned va0[2], va1[2];
            if constexpr (GA) { va0[0] = last ? vn0[0] : vc0[0]; va0[1] = last ? vn0[1] : vc0[1]; va1[0] = last ? vn1[0] : vc1[0]; va1[1] = last ? vn1[1] : vc1[1]; }
            PG8_LDB(B0, 0, 0); PG8_LDB(B1, 0, 1); PG8_SCHED; PG8_LDA(At, 0, 0); if constexpr (GA) PG8_STAGE(PG8_SA(1, 1), a1, vc1); else PG8_STAGE(PG8_SA(1, 1), a1 + hstep, voffA);
            PG8_WAIT_V(8); PG8_WAIT_L(0); PG8_BAR; PG8_MMA(0, 0, At, B0); PG8_MMA(0, 1, At, B1); PG8_BAR; PG8_SCHED;
            PG8_LDA(At, 0, 1); PG8_STAGE(PG8_SB(0, 0), b2, voffB); PG8_STAGE(PG8_SB(0, 1), b2 + hstep, voffB); if constexpr (GA) PG8_STAGE(PG8_SA(0, 0), a2, va0); else PG8_STAGE(PG8_SA(0, 0), a2, voffA);
            PG8_WAIT_V(8); PG8_WAIT_L(0); PG8_BAR; PG8_MMA(1, 0, At, B0); PG8_MMA(1, 1, At, B1); PG8_BAR; PG8_SCHED;
            PG8_LDB(B0, 1, 0); PG8_LDB(B1, 1, 1); PG8_SCHED; PG8_LDA(At, 1, 0); if constexpr (GA) PG8_STAGE(PG8_SA(0, 1), a2, va1); else PG8_STAGE(PG8_SA(0, 1), a2 + hstep, voffA);
            PG8_WAIT_V(8); PG8_WAIT_L(0); PG8_BAR; PG8_MMA(0, 0, At, B0); PG8_MMA(0, 1, At, B1); PG8_BAR; PG8_SCHED;
            PG8_LDA(At, 1, 1); PG8_STAGE(PG8_SB(1, 0), b3, voffB); PG8_STAGE(PG8_SB(1, 1), b3 + hstep, voffB); if constexpr (GA) PG8_STAGE(PG8_SA(1, 0), a3, va0); else PG8_STAGE(PG8_SA(1, 0), a3, voffA);
            PG8_WAIT_V(8); PG8_WAIT_L(0); PG8_BAR; PG8_MMA(1, 0, At, B0); PG8_MMA(1, 1, At, B1); PG8_BAR; PG8_SCHED;
            } else {
            PG8_LDB(B0, 0, 0); PG8_SCHED; PG8_LDA(At, 0, 0); PG8_STAGE(PG8_SA(1, 1), a1 + hstep, voffA);
            PG8_WAIT_L(8); PG8_BAR; PG8_WAIT_L(0); PG8_MMA(0, 0, At, B0); PG8_BAR; PG8_SCHED;
            PG8_LDB(B1, 0, 1); PG8_STAGE(PG8_SB(0, 0), b2, voffB);
            PG8_BAR; PG8_WAIT_L(0); PG8_MMA(0, 1, At, B1); PG8_BAR;
            PG8_LDA(At, 0, 1); PG8_STAGE(PG8_SA(0, 0), a2, voffA);
            PG8_BAR; PG8_WAIT_L(0); PG8_MMA(1, 0, At, B0); PG8_BAR; PG8_SCHED;
            PG8_STAGE(PG8_SB(0, 1), b2 + hstep, voffB);
            PG8_WAIT_V(6); PG8_BAR; PG8_MMA(1, 1, At, B1); PG8_BAR;
            PG8_LDB(B0, 1, 0); PG8_SCHED; PG8_LDA(At, 1, 0); PG8_STAGE(PG8_SA(0, 1), a2 + hstep, voffA);
            PG8_WAIT_L(8); PG8_BAR; PG8_WAIT_L(0); PG8_MMA(0, 0, At, B0); PG8_BAR; PG8_SCHED;
            PG8_LDB(B1, 1, 1); PG8_STAGE(PG8_SB(1, 0), b3, voffB);
            PG8_BAR; PG8_WAIT_L(0); PG8_MMA(0, 1, At, B1); PG8_BAR;
            PG8_LDA(At, 1, 1); PG8_STAGE(PG8_SA(1, 0), a3, voffA);
            PG8_BAR; PG8_WAIT_L(0); PG8_MMA(1, 0, At, B0); PG8_BAR; PG8_SCHED;
            PG8_STAGE(PG8_SB(1, 1), b3 + hstep, voffB);
            PG8_WAIT_V(6); PG8_BAR; PG8_MMA(1, 1, At, B1); PG8_BAR;
            }
        }
        if constexpr (ALIGN_EPI) { if (wr == 0) PG8_BAR; }
        if constexpr (!Epi::AFTER_DRAIN) { E(acc, cur, wr, wc, fr, fq); S.done(cur); }
        if (!has_next) break;
#pragma unroll
        for (int a = 0; a < 2; ++a)
#pragma unroll
            for (int b = 0; b < 2; ++b)
#pragma unroll
                for (int m = 0; m < 4; ++m)
#pragma unroll
                    for (int n = 0; n < 2; ++n) acc[a][b][m][n] = (f32x4){0.f, 0.f, 0.f, 0.f};
        cur = nxt; cA = nA; cB = nB; ++ui;
        if constexpr (GA) { vc0[0] = vn0[0]; vc0[1] = vn0[1]; vc1[0] = vn1[0]; vc1[1] = vn1[1]; }
        if constexpr (ALIGN_EPI) { if (wr == 1) PG8_BAR; }
    }
    PG8_WAIT_V(0);
    if constexpr (!ALIGN_EPI) { if (wr == 0) PG8_BAR; }
    PG8_BAR;
    if constexpr (Epi::AFTER_DRAIN) { E.fused(acc, cur, wr, wc, fr, fq, lds, wid, lane); S.done(cur); }
#undef PG8_SA
#undef PG8_SB
#undef PG8_STAGE
#undef PG8_GOFF
#undef PG8_LDA
#undef PG8_LDB
#undef PG8_MMA
#undef PG8_WAIT_V
#undef PG8_WAIT_L
#undef PG8_BAR
#undef PG8_SCHED
}
}

constexpr int S = 16384, D = 1024, DEPTH = 4, DPROJ = 2560, DFF = 2816, NEXP = 8;
#ifndef PPITCH_V
#define PPITCH_V 2688
#endif
constexpr int PPITCH = PPITCH_V;
constexpr int O_QSB = 0, O_KSB = 256, O_VSB = 512, O_QCA = 768, O_KCA = 1280, O_VCA = 1792, O_U = 2304;
constexpr int NWAVES = 8;
constexpr float LOG2E = 1.4426950408889634f;
constexpr float QSCALE = 0.125f * LOG2E;
constexpr float SB_STOP = -40.f;
#ifndef WGM_INPROJ
#define WGM_INPROJ 4
#endif
#ifndef WGM_GLU
#define WGM_GLU 4
#endif
#ifndef WGM_OUT
#define WGM_OUT 4
#endif
#ifndef WGM_DND
#define WGM_DND 4
#endif
#ifndef WGM_GUD
#define WGM_GUD 4
#endif
#ifndef WGM_GUM
#define WGM_GUM 4
#endif
#ifndef WGM_DNM
#define WGM_DNM 4
#endif
#ifndef FILL_B1
#define FILL_B1 8
#endif
#ifndef FILL_GLU
#define FILL_GLU 4
#endif
#ifndef FILL_MDN2
#define FILL_MDN2 0
#endif
#ifndef FILL_MDN
#define FILL_MDN 20
#endif
#ifndef MK_ONE_LAUNCH
#define MK_ONE_LAUNCH 1
#endif
constexpr bool ONE_LAUNCH = MK_ONE_LAUNCH;
constexpr int PH_PER_LAYER = 11, N_PHASES = 1 + DEPTH * PH_PER_LAYER + 1;

constexpr size_t MiB = 1u << 20;
constexpr size_t WS_CTL = 0, CTL_ZERO_BYTES = 1 * MiB;
constexpr size_t WS_TOKE = 1 * MiB, WS_TOKPOS = WS_TOKE + 128 * 1024, WS_TOKG = WS_TOKPOS + 128 * 1024, WS_TOKSLOT = WS_TOKG + 128 * 1024;
constexpr size_t WS_SEND = 2 * MiB;
constexpr size_t WS_SLOTTOK = 3 * MiB;
constexpr size_t WS_WIN = 4 * MiB, WIN_BYTES = (size_t)DPROJ * D * 2;
constexpr size_t WS_WGLU = 24 * MiB, WGLU_BYTES = 512 * 256 * 2;
constexpr size_t WS_WOUT = 25 * MiB, WOUT_BYTES = (size_t)D * D * 2;
constexpr size_t WS_GU = 33 * MiB, GU_BYTES = (size_t)2 * DFF * D * 2;
constexpr size_t WS_DN = 231 * MiB, DN_BYTES = (size_t)D * DFF * 2;
constexpr size_t WS_H = 330 * MiB;
constexpr size_t WS_R1 = 362 * MiB;
constexpr size_t WS_PROJ = WS_R1, WS_MIXRAW = WS_R1 + 96 * MiB, WS_MIXN = WS_R1 + 128 * MiB, WS_YG = WS_R1 + 160 * MiB;
static_assert((size_t)16384 * PPITCH * 2 <= 96 * MiB, "PROJ fits its slot");
constexpr size_t WS_R2 = 549 * MiB;
constexpr size_t WS_SS = 617 * MiB;
constexpr size_t SS_A = WS_SS, SS_B = WS_SS + 1 * MiB, SSQ_SSM = WS_SS + 2 * MiB, SSQ_SB = SSQ_SSM + 512 * 1024, SSQ_CA = SSQ_SB + 256 * 1024, RSTD_TOK = SSQ_CA + 512 * 1024, SLOT_RS = RSTD_TOK + 64 * 1024, RSTD_A = SLOT_RS + 192 * 1024, RSTD_B = RSTD_A + 64 * 1024;
constexpr size_t WS_TAB = 621 * MiB;
constexpr size_t TAB_A = WS_TAB, TAB_B = WS_TAB + 65536;
constexpr size_t WS_Y2 = 622 * MiB;
constexpr size_t WS_END = 690 * MiB;
constexpr int MAXTILES = 136;
constexpr int CW_SSMF = 8192;
constexpr int CW_BAR = 4096;
constexpr int CW_WGCNT = 20480;
constexpr int CW_MOE = 16384, MOE_WORDS = 1024;

constexpr int WAVE_LDS = 17920;
constexpr int MISC_OFF = 8 * WAVE_LDS;
constexpr int RS_OFF = 131072;
constexpr int LDS_BYTES = 147456;

#define GAS __attribute__((address_space(1)))
#define LAS __attribute__((address_space(3)))
typedef unsigned short bf16;
typedef unsigned v4u __attribute__((ext_vector_type(4)));
typedef unsigned v2u __attribute__((ext_vector_type(2)));
typedef float f32x4 __attribute__((ext_vector_type(4)));
#define LDS_WAIT() asm volatile("s_waitcnt lgkmcnt(0)" ::: "memory")
#define VM_WAIT() asm volatile("s_waitcnt vmcnt(0)" ::: "memory")
__device__ __forceinline__ float bf_lo(unsigned u) { return __builtin_bit_cast(float, u << 16); }
__device__ __forceinline__ float bf_hi(unsigned u) { return __builtin_bit_cast(float, u & 0xffff0000u); }
__device__ __forceinline__ unsigned pk2(float lo, float hi) { return pg8::cvt_pk_bf16(lo, hi); }
__device__ __forceinline__ float wave_sum(float v) {
#pragma unroll
    for (int o = 1; o < 64; o <<= 1) v += __shfl_xor(v, o);
    return v;
}
__device__ __forceinline__ float fexp2(float x) { return __builtin_amdgcn_exp2f(x); }
__device__ __forceinline__ float flog2(float x) { return __builtin_amdgcn_logf(x); }

struct Args { const float* in[27]; float* out; unsigned char* ws; int ph_lo, ph_hi; };

__device__ __forceinline__ void conv_item(const float* __restrict__ W, int K, int N, bf16* __restrict__ WT, int mode, LAS float* scr, int item, int lane, const float* __restrict__ gk = nullptr, bool kperm = false) {
    const int nblk = N / 32, kb = item / nblk, nb = item % nblk, k0 = 64 * kb, n0 = 32 * nb;
    const int c = lane & 7;
    f32x4 g0 = (f32x4){1.f, 1.f, 1.f, 1.f}, g1 = g0;
    if (gk) { g0 = *(const f32x4*)(gk + k0 + 8 * c); g1 = *(const f32x4*)(gk + k0 + 8 * c + 4); }
    float wv[32];
#pragma unroll
    for (int i = 0; i < 32; ++i) wv[i] = W[(size_t)(k0 + 2 * i + (lane >> 5)) * N + n0 + (lane & 31)];
#pragma unroll
    for (int i = 0; i < 32; ++i) scr[(2 * i + (lane >> 5)) * 33 + (lane & 31)] = wv[i];
    LDS_WAIT();
    int r0 = n0;
    if (mode == 1) { const int pn = n0 >> 8, nl = n0 & 255; r0 = 256 * pn + 128 * ((nl >> 5) & 1) + 32 * (nl >> 6); }
    else if (mode == 2) { const int hi = n0 >= 256, nn = n0 & 255; r0 = 256 * (nn >> 7) + 128 * hi + (nn & 127); }
    else if (mode == 3) { r0 = 256 * (n0 >> 7) + (n0 & 127); }
    else if (mode == 4) { r0 = 256 * (n0 >> 7) + 128 + (n0 & 127); }
    const int kd0 = kperm ? (k0 >= 768 ? k0 - 768 : k0 + 256) : k0;
#pragma unroll
    for (int j = 0; j < 4; ++j) { const int n = (lane >> 3) + 8 * j; const LAS float* s = scr + (8 * c) * 33 + n;
        v4u o; o.x = pk2(s[0 * 33] * g0[0], s[1 * 33] * g0[1]); o.y = pk2(s[2 * 33] * g0[2], s[3 * 33] * g0[3]); o.z = pk2(s[4 * 33] * g1[0], s[5 * 33] * g1[1]); o.w = pk2(s[6 * 33] * g1[2], s[7 * 33] * g1[3]);
        *(v4u*)(WT + (size_t)(r0 + n) * K + kd0 + 8 * c) = o; }
    LDS_WAIT();
}
constexpr int IT_IN = (D / 64) * (DPROJ / 32), IT_GLU = (256 / 64) * (512 / 32), IT_OUT = (D / 64) * (D / 32), IT_FF = (D / 64) * (DFF / 32);
static_assert(IT_FF == (DFF / 64) * (D / 32), "gate/up and down have the same item count");
constexpr int IT_B = IT_IN + IT_GLU + IT_OUT, IT_F = 3 * IT_FF, IT_M = NEXP * IT_F;
constexpr int CV_B0 = IT_B, CV_F0 = CV_B0 + IT_F, CV_B1 = CV_F0 + IT_B, CV_M1 = CV_B1 + IT_M, CV_B2 = CV_M1 + IT_B, CV_F1 = CV_B2 + IT_F, CV_B3 = CV_F1 + IT_B, CV_M3 = CV_B3 + IT_M, NIT_TOTAL = CV_M3;
typedef const Args __attribute__((address_space(4)))* CArgsP;
__device__ __forceinline__ void conv_B(CArgsP ap, int l, int r, LAS float* scr, int lane) {
    unsigned char* ws = ap->ws;
    if (r < IT_IN) conv_item(ap->in[2] + (size_t)l * D * DPROJ, D, DPROJ, (bf16*)(ws + WS_WIN + l * WIN_BYTES), 1, scr, r, lane, ap->in[1] + (size_t)l * D);
    else if (r < IT_IN + IT_GLU) conv_item(ap->in[16] + (size_t)l * 256 * 512, 256, 512, (bf16*)(ws + WS_WGLU + l * WGLU_BYTES), 2, scr, r - IT_IN, lane);
    else conv_item(ap->in[18] + (size_t)l * D * D, D, D, (bf16*)(ws + WS_WOUT + l * WOUT_BYTES), 0, scr, r - IT_IN - IT_GLU, lane, ap->in[17] + (size_t)l * D, true);
}
__device__ __forceinline__ void conv_F(CArgsP ap, int f, int r, LAS float* scr, int lane) {
    unsigned char* ws = ap->ws;
    const int which = r / IT_FF, idx = r % IT_FF; const size_t mo = (size_t)(f < 2 ? f : f - 2) * D * DFF;
    const float* gk = ap->in[19] + (size_t)(f < 2 ? 2 * f : (f < 10 ? 1 : 3)) * D;
    if (which == 0) conv_item((f < 2 ? ap->in[20] : ap->in[24]) + mo, D, DFF, (bf16*)(ws + WS_GU + f * GU_BYTES), 3, scr, idx, lane, gk);
    else if (which == 1) conv_item((f < 2 ? ap->in[21] : ap->in[25]) + mo, D, DFF, (bf16*)(ws + WS_GU + f * GU_BYTES), 4, scr, idx, lane, gk);
    else conv_item((f < 2 ? ap->in[22] : ap->in[26]) + mo, DFF, D, (bf16*)(ws + WS_DN + f * DN_BYTES), 0, scr, idx, lane);
}
__device__ __forceinline__ void conv_one(CArgsP ap, int it, LAS float* scr, int lane) {
    int r = it;
    if (r < CV_B0) { conv_B(ap, 0, r, scr, lane); return; } r -= IT_B;
    if (r < IT_F) { conv_F(ap, 0, r, scr, lane); return; } r -= IT_F;
    if (r < IT_B) { conv_B(ap, 1, r, scr, lane); return; } r -= IT_B;
    if (r < IT_M) { conv_F(ap, 2 + r / IT_F, r % IT_F, scr, lane); return; } r -= IT_M;
    if (r < IT_B) { conv_B(ap, 2, r, scr, lane); return; } r -= IT_B;
    if (r < IT_F) { conv_F(ap, 1, r, scr, lane); return; } r -= IT_F;
    if (r < IT_B) { conv_B(ap, 3, r, scr, lane); return; } r -= IT_B;
    conv_F(ap, 10 + r / IT_F, r % IT_F, scr, lane);
}
__device__ __forceinline__ void conv_fill(CArgsP ap, int& cvc, int first_cu, int budget, LAS float* scr, int wave, int lane) {
    const int G = gridDim.x, bx = blockIdx.x, nsw = (G - first_cu) * NWAVES, n = nsw * budget;
    int b = cvc + n; if (b > NIT_TOTAL) b = NIT_TOTAL;
    if (bx >= first_cu) for (int it = cvc + (bx - first_cu) * NWAVES + wave; it < b; it += nsw) conv_one(ap, it, scr, lane);
    cvc = b;
}
__device__ __forceinline__ void conv_drain(CArgsP ap, int& cvc, int required, LAS float* scr, int wave, int lane) {
    if (cvc >= required) return;
    const int nsw = gridDim.x * NWAVES;
    for (int it = cvc + blockIdx.x * NWAVES + wave; it < required; it += nsw) conv_one(ap, it, scr, lane);
    cvc = required;
}

__device__ __forceinline__ void row_phase(const float* __restrict__ xsrc, float* __restrict__ X, bool writeX, const bf16* __restrict__ Y, const bf16* __restrict__ Y2, const int* __restrict__ split, const int* __restrict__ tok_slot, const float* __restrict__ tok_g,
                                          bf16* __restrict__ XB, float* __restrict__ rstd_out, int gw, int NGW, int lane, float oscale = 1.f) {
    for (int row0 = gw; row0 < S; row0 += 2 * NGW) {
        const bool two = row0 + NGW < S;
        f32x4 v[2][4]; int s0[2], s1[2]; float g0[2], g1[2];
#pragma unroll
        for (int j = 0; j < 2; ++j) { const int row = (j == 0 || two) ? row0 + j * NGW : row0;
#pragma unroll
            for (int i = 0; i < 4; ++i) v[j][i] = *(const f32x4*)(xsrc + (size_t)row * D + 4 * lane + 256 * i);
            if (Y) { s0[j] = tok_slot[2 * row]; s1[j] = tok_slot[2 * row + 1]; g0[j] = tok_g[2 * row]; g1[j] = tok_g[2 * row + 1]; } }
        if (Y) {
            v2u a[2][4], b[2][4]; int k0[2], k1[2];
#pragma unroll
            for (int j = 0; j < 2; ++j) {
#pragma unroll
                for (int i = 0; i < 4; ++i) { a[j][i] = *(const v2u*)(Y + (size_t)s0[j] * D + 4 * lane + 256 * i); b[j][i] = *(const v2u*)(Y + (size_t)s1[j] * D + 4 * lane + 256 * i); }
                k0[j] = split[s0[j] >> 8]; k1[j] = split[s1[j] >> 8]; }
#pragma unroll
            for (int j = 0; j < 2; ++j) {
#pragma unroll
                for (int i = 0; i < 4; ++i) { v[j][i][0] += g0[j] * bf_lo(a[j][i].x) + g1[j] * bf_lo(b[j][i].x); v[j][i][1] += g0[j] * bf_hi(a[j][i].x) + g1[j] * bf_hi(b[j][i].x);
                    v[j][i][2] += g0[j] * bf_lo(a[j][i].y) + g1[j] * bf_lo(b[j][i].y); v[j][i][3] += g0[j] * bf_hi(a[j][i].y) + g1[j] * bf_hi(b[j][i].y); }
                if (k0[j] | k1[j]) {
#pragma unroll
                    for (int i = 0; i < 4; ++i) {
                        if ((k0[j] >> i) & 1) { const v2u c = *(const v2u*)(Y2 + (size_t)s0[j] * D + 4 * lane + 256 * i); v[j][i][0] += g0[j] * bf_lo(c.x); v[j][i][1] += g0[j] * bf_hi(c.x); v[j][i][2] += g0[j] * bf_lo(c.y); v[j][i][3] += g0[j] * bf_hi(c.y); }
                        if ((k1[j] >> i) & 1) { const v2u c = *(const v2u*)(Y2 + (size_t)s1[j] * D + 4 * lane + 256 * i); v[j][i][0] += g1[j] * bf_lo(c.x); v[j][i][1] += g1[j] * bf_hi(c.x); v[j][i][2] += g1[j] * bf_lo(c.y); v[j][i][3] += g1[j] * bf_hi(c.y); }
                    }
                }
            }
        }
#pragma unroll
        for (int j = 0; j < 2; ++j) { if (j == 1 && !two) break; const int row = row0 + j * NGW;
            if (writeX) {
#pragma unroll
                for (int i = 0; i < 4; ++i) *(f32x4*)(X + (size_t)row * D + 4 * lane + 256 * i) = v[j][i] * oscale;
            }
            if (!XB) continue;
            float sq = 0.f;
#pragma unroll
            for (int i = 0; i < 4; ++i) { sq += v[j][i][0] * v[j][i][0] + v[j][i][1] * v[j][i][1] + v[j][i][2] * v[j][i][2] + v[j][i][3] * v[j][i][3]; v2u o; o.x = pk2(v[j][i][0], v[j][i][1]); o.y = pk2(v[j][i][2], v[j][i][3]); *(v2u*)(XB + (size_t)row * D + 4 * lane + 256 * i) = o; }
            sq = wave_sum(sq);
            if (lane < 16) rstd_out[(size_t)row * 16 + lane] = (lane == 0) ? sq : 0.f;
        }
    }
}
__device__ __forceinline__ void route_phase(const float* __restrict__ X, const float* __restrict__ gain, const float* __restrict__ Wr, int* __restrict__ wgcnt, float* tok_gw,
                                            int gw, int NGW, int lane, LAS float* wr_s, int tid, int& o_row, int& o_e0, int& o_e1, int& o_p0, int& o_p1, float& o_r) {
    for (int idx = tid; idx < 8192; idx += NWAVES * 64) wr_s[(idx & 7) * 1024 + (idx >> 3)] = Wr[idx];
    if (tid < 128) ((LAS int*)(wr_s + 8192))[tid] = 0;
    __syncthreads();
    LAS int* cnt_s = (LAS int*)(wr_s + 8192); LAS int* loc_s = cnt_s + 128 + (tid >> 6) * 64;
    LAS int* wcnt = cnt_s + 8 * (tid >> 6);
    int krow = 0;
    f32x4 gv[4];
#pragma unroll
    for (int i = 0; i < 4; ++i) gv[i] = *(const f32x4*)(gain + 4 * lane + 256 * i);
    for (int row = gw; row < S; row += NGW) {
        f32x4 v[4];
#pragma unroll
        for (int i = 0; i < 4; ++i) v[i] = *(const f32x4*)(X + (size_t)row * D + 4 * lane + 256 * i);
        float sq = 0.f;
#pragma unroll
        for (int i = 0; i < 4; ++i) sq += v[i][0] * v[i][0] + v[i][1] * v[i][1] + v[i][2] * v[i][2] + v[i][3] * v[i][3];
        const float r = rsqrtf(wave_sum(sq) * (1.f / D) + 1e-6f);
#pragma unroll
        for (int i = 0; i < 4; ++i) v[i] = v[i] * r * gv[i];
        float lg[8];
#pragma unroll
        for (int e = 0; e < 8; ++e) lg[e] = 0.f;
#pragma unroll
        for (int e = 0; e < 8; ++e)
#pragma unroll
            for (int i = 0; i < 4; ++i) { const f32x4 w = *(const LAS f32x4*)(wr_s + e * 1024 + 4 * lane + 256 * i); lg[e] += v[i][0] * w[0] + v[i][1] * w[1] + v[i][2] * w[2] + v[i][3] * w[3]; }
#pragma unroll
        for (int e = 0; e < 8; ++e) lg[e] = wave_sum(lg[e]);
        if (lane == 0) {
            int e0 = 0;
#pragma unroll
            for (int e = 1; e < 8; ++e) if (lg[e] > lg[e0]) e0 = e;
            int e1 = (e0 == 0) ? 1 : 0;
#pragma unroll
            for (int e = 0; e < 8; ++e) if (e != e0 && lg[e] > lg[e1]) e1 = e;
            asm volatile("" : "+v"(e0), "+v"(e1));
            const float g1 = 1.f / (1.f + __expf(lg[e0] - lg[e1]));
            tok_gw[2 * row] = 1.f - g1; tok_gw[2 * row + 1] = g1;
            const int r0 = wcnt[e0]; wcnt[e0] = r0 + 1; const int r1 = wcnt[e1]; wcnt[e1] = r1 + 1;
            loc_s[8 * krow] = e0; loc_s[8 * krow + 1] = e1; loc_s[8 * krow + 2] = r0; loc_s[8 * krow + 3] = r1; loc_s[8 * krow + 4] = __float_as_int(r);
        }
        ++krow;
    }
    __syncthreads();
    if (tid < 8) { int run = 0;
#pragma unroll
        for (int w = 0; w < 8; ++w) { cnt_s[64 + 8 * w + tid] = run; run += cnt_s[8 * w + tid]; }
        __hip_atomic_store(wgcnt + blockIdx.x * 8 + tid, run, __ATOMIC_RELAXED, __HIP_MEMORY_SCOPE_AGENT); }
    __syncthreads();
    o_row = -1; o_e0 = 0; o_e1 = 0; o_p0 = 0; o_p1 = 0; o_r = 0.f;
    if (lane < krow) { o_row = gw + lane * NGW; o_e0 = loc_s[8 * lane]; o_e1 = loc_s[8 * lane + 1]; LAS int* pw = cnt_s + 64 + 8 * (tid >> 6);
        o_p0 = pw[o_e0] + loc_s[8 * lane + 2]; o_p1 = pw[o_e1] + loc_s[8 * lane + 3]; o_r = __int_as_float(loc_s[8 * lane + 4]); }
}
__device__ __forceinline__ void perm_phase(int* mctl, const int* __restrict__ wgcnt, int* __restrict__ tok_slot, int* __restrict__ slot_tok, float* __restrict__ slot_rs, LAS int* pre  ,
                                           int gw, int lane, int tid, int row, int e0, int e1, int p0, int p1, float r) {
    __syncthreads();
    if ((int)gridDim.x == 256) {
        const int e = tid >> 6; int c[4];
#pragma unroll
        for (int j = 0; j < 4; ++j) c[j] = wgcnt[(4 * lane + j) * 8 + e];
        const int t4 = (c[0] + c[1]) + (c[2] + c[3]); int incl = t4;
#pragma unroll
        for (int d = 1; d < 64; d <<= 1) { const int o = __shfl_up(incl, d); incl += (lane >= d) ? o : 0; }
        const int ex = incl - t4;
        pre[(4 * lane) * 8 + e] = ex; pre[(4 * lane + 1) * 8 + e] = ex + c[0]; pre[(4 * lane + 2) * 8 + e] = ex + c[0] + c[1]; pre[(4 * lane + 3) * 8 + e] = ex + c[0] + c[1] + c[2];
        if (lane == 63) pre[2048 + e] = incl;
    } else if (tid < 8) { int run = 0; for (int b = 0; b < (int)gridDim.x; ++b) { pre[b * 8 + tid] = run; run += wgcnt[b * 8 + tid]; } pre[2048 + tid] = run; }
    __syncthreads();
    int base[8]; int off = 0;
#pragma unroll
    for (int e = 0; e < 8; ++e) { base[e] = off; off += ((pre[2048 + e] + 255) >> 8) << 8; }
    if (gw == 0 && lane == 0) {
        int nt = 0;
        for (int e = 0; e < 8; ++e) { const int tl = (pre[2048 + e] + 255) >> 8; for (int i = 0; i < tl; ++i) mctl[32 + nt + i] = e; nt += tl; }
        mctl[16] = nt;
        const int units = nt * (D / 256);
        if ((int)gridDim.x == 256 && units > 512) { pg8::StaticOrder so; so.init(nt * 256, D, 256, 0, WGM_DNM);
            for (int L = 512; L < units; ++L) { pg8::Unit u; so.unit_of(L, u); mctl[256 + u.pm] |= 1 << u.pn; } }
    }
    if (row >= 0) {
        int b0 = base[0], b1 = base[0];
#pragma unroll
        for (int k = 1; k < 8; ++k) { b0 = (e0 == k) ? base[k] : b0; b1 = (e1 == k) ? base[k] : b1; }
        const int s0 = b0 + pre[blockIdx.x * 8 + e0] + p0, s1 = b1 + pre[blockIdx.x * 8 + e1] + p1;
        tok_slot[2 * row] = s0; tok_slot[2 * row + 1] = s1; slot_tok[s0] = row; slot_tok[s1] = row; slot_rs[s0] = r; slot_rs[s1] = r;
    }
    if (gw < 8) { const int e = gw; int b = base[0], nb = off;
#pragma unroll
        for (int k = 1; k < 8; ++k) { b = (e == k) ? base[k] : b; }
#pragma unroll
        for (int k = 1; k < 8; ++k) { nb = (e == k - 1) ? base[k] : nb; }
        for (int s = b + pre[2048 + e] + lane; s < nb; s += 64) slot_tok[s] = 0; }
    __syncthreads();
}

struct SsmPar { const float *lam_re, *lam_im, *log_dt, *b_re, *b_im, *c_re, *c_im, *d_skip; };
__device__ __forceinline__ void ssm_coef(const SsmPar& sp, int g, int p, float& are, float& aim, float (&bbr)[16], float (&bbi)[16]) {
    const float dt = expf(sp.log_dt[g]); const float lre = sp.lam_re[g * 64 + p], lim = sp.lam_im[g * 64 + p];
    const float mag = expf(lre * dt), ang = lim * dt; are = mag * cosf(ang); aim = mag * sinf(ang);
    const float nre = are - 1.f, nim = aim, den = lre * lre + lim * lim;
    const float zre = (nre * lre + nim * lim) / den, zim = (nim * lre - nre * lim) / den;
#pragma unroll
    for (int c = 0; c < 16; ++c) { const float br = sp.b_re[(g * 64 + p) * 16 + c], bi = sp.b_im[(g * 64 + p) * 16 + c]; bbr[c] = zre * br - zim * bi; bbi[c] = zre * bi + zim * br; }
}
typedef short sbf16x8 __attribute__((ext_vector_type(8)));

__device__ __forceinline__ void ssm_table_task(const SsmPar& sp, float2* __restrict__ atab, bf16* __restrict__ btab, int lg  , int g, int lane) {
    float are, aim, bbr[16], bbi[16]; ssm_coef(sp, g, lane, are, aim, bbr, bbi);
    atab[(size_t)lg * 64 + lane] = make_float2(are, aim);
    v4u w0, w1, w2, w3;
    w0.x = pk2(bbr[0], bbr[1]); w0.y = pk2(bbr[2], bbr[3]); w0.z = pk2(bbr[4], bbr[5]); w0.w = pk2(bbr[6], bbr[7]);
    w1.x = pk2(bbr[8], bbr[9]); w1.y = pk2(bbr[10], bbr[11]); w1.z = pk2(bbr[12], bbr[13]); w1.w = pk2(bbr[14], bbr[15]);
    w2.x = pk2(bbi[0], bbi[1]); w2.y = pk2(bbi[2], bbi[3]); w2.z = pk2(bbi[4], bbi[5]); w2.w = pk2(bbi[6], bbi[7]);
    w3.x = pk2(bbi[8], bbi[9]); w3.y = pk2(bbi[10], bbi[11]); w3.z = pk2(bbi[12], bbi[13]); w3.w = pk2(bbi[14], bbi[15]);
    v4u* d = (v4u*)(btab + ((size_t)lg * 128 + 2 * lane) * 16);
    d[0] = w0; d[1] = w1; d[2] = w2; d[3] = w3;
}
typedef float f32x16s __attribute__((ext_vector_type(16)));
typedef float f32x2v __attribute__((ext_vector_type(2)));
constexpr int BU_PITCH = 528;
__device__ __forceinline__ void ssm_bu_mfma(f32x16s (&D)[4], const sbf16x8 (&af)[4], const bf16* __restrict__ P, int tok0, int g, int lane) {
    const int r = lane & 31, h = lane >> 5;
    const sbf16x8 bfr = *(const sbf16x8*)(P + (size_t)(tok0 + r) * PPITCH + O_U + g * 16 + 8 * h);
#pragma unroll
    for (int mt = 0; mt < 4; ++mt) { f32x16s z;
#pragma unroll
        for (int i = 0; i < 16; ++i) z[i] = 0.f;
        D[mt] = __builtin_amdgcn_mfma_f32_32x32x16_bf16(af[mt], bfr, z, 0, 0, 0); }
}
__device__ __forceinline__ void ssm_bu_store(const f32x16s (&D)[4], LAS unsigned char* bu, int sub, int lane) {
    const int r = lane & 31, h = lane >> 5;
    if ((r >> 4) == sub) {
#pragma unroll
        for (int mt = 0; mt < 4; ++mt)
#pragma unroll
            for (int g4 = 0; g4 < 4; ++g4) *(LAS f32x4*)(bu + (r & 15) * BU_PITCH + (32 * mt + 8 * g4 + 4 * h) * 4) = (f32x4){D[mt][4 * g4], D[mt][4 * g4 + 1], D[mt][4 * g4 + 2], D[mt][4 * g4 + 3]};
    }
}
__device__ __forceinline__ void ssm_load_af(sbf16x8 (&af)[4], const bf16* __restrict__ btab, int lg, int lane) {
    const int r = lane & 31, h = lane >> 5;
#pragma unroll
    for (int mt = 0; mt < 4; ++mt) af[mt] = *(const sbf16x8*)(btab + ((size_t)lg * 128 + 32 * mt + r) * 16 + 8 * h);
}
__device__ __forceinline__ void ssm_a2_task(const bf16* __restrict__ P, const float2* __restrict__ atab, const bf16* __restrict__ btab, float2* __restrict__ Send, LAS unsigned char* wl, int lg, int g, int cp, int lane) {
    const float2 a = atab[(size_t)lg * 64 + lane]; const float are = a.x, aim = a.y;
    sbf16x8 af[4]; ssm_load_af(af, btab, lg, lane);
    float xr = 0.f, xi = 0.f;
    for (int nt = 0; nt < 4; ++nt) {
        f32x16s Dt[4]; ssm_bu_mfma(Dt, af, P, cp * 128 + 32 * nt, g, lane);
#pragma unroll
        for (int sub = 0; sub < 2; ++sub) {
            LDS_WAIT();
            ssm_bu_store(Dt, wl, sub, lane);
            LDS_WAIT();
#pragma unroll 4
            for (int s = 0; s < 16; ++s) { const f32x2v b = *(const LAS f32x2v*)(wl + s * BU_PITCH + lane * 8); const float nr = are * xr - aim * xi + b.x, ni = are * xi + aim * xr + b.y; xr = nr; xi = ni; }
        }
    }
    __hip_atomic_store((unsigned long long*)(Send + ((size_t)g * 128 + cp) * 64 + lane), ((unsigned long long)__float_as_uint(xi) << 32) | (unsigned long long)__float_as_uint(xr), __ATOMIC_RELAXED, __HIP_MEMORY_SCOPE_AGENT);
}
__device__ __forceinline__ void ssm_c2_task(const bf16* __restrict__ P, const SsmPar& sp, const float2* __restrict__ atab, const bf16* __restrict__ btab, const float2* __restrict__ Send, bf16* __restrict__ YG,
                                            LAS unsigned char* wl, int lg, int g, int cp, int lane) {
    const float2 a = atab[(size_t)lg * 64 + lane]; const float are = a.x, aim = a.y;
    sbf16x8 af[4]; ssm_load_af(af, btab, lg, lane);
    LAS unsigned char* bu = wl;
    LAS unsigned char* xs = wl + 8448;
    const int fr = lane & 15, fq = lane >> 4;
    sbf16x8 cf[4];
#pragma unroll
    for (int kk = 0; kk < 4; ++kk) {
        const f32x4 cr = *(const f32x4*)(sp.c_re + (size_t)(g * 16 + fr) * 64 + 16 * kk + 4 * fq), ci = *(const f32x4*)(sp.c_im + (size_t)(g * 16 + fr) * 64 + 16 * kk + 4 * fq);
        v4u w; w.x = pk2(cr[0], -ci[0]); w.y = pk2(cr[1], -ci[1]); w.z = pk2(cr[2], -ci[2]); w.w = pk2(cr[3], -ci[3]);
        cf[kk] = __builtin_bit_cast(sbf16x8, w);
    }
    const f32x4 dsk = *(const f32x4*)(sp.d_skip + g * 16 + 4 * fq);
    float pr = are, pi = aim;
#pragma unroll
    for (int i = 0; i < 7; ++i) { const float nr = pr * pr - pi * pi, ni = 2.f * pr * pi; pr = nr; pi = ni; }
    float xr = 0.f, xi = 0.f;
    {
        const float2* sp0 = Send + (size_t)g * 128 * 64 + lane; const int nc = cp; int c = 0;
        for (; c + 64 <= nc; c += 64) { float2 s[64];
#pragma unroll
            for (int j = 0; j < 64; ++j) s[j] = sp0[(size_t)(c + j) * 64];
#pragma unroll
            for (int j = 0; j < 64; ++j) { const float nr = pr * xr - pi * xi + s[j].x, ni = pr * xi + pi * xr + s[j].y; xr = nr; xi = ni; } }
        for (; c + 32 <= nc; c += 32) { float2 s[32];
#pragma unroll
            for (int j = 0; j < 32; ++j) s[j] = sp0[(size_t)(c + j) * 64];
#pragma unroll
            for (int j = 0; j < 32; ++j) { const float nr = pr * xr - pi * xi + s[j].x, ni = pr * xi + pi * xr + s[j].y; xr = nr; xi = ni; } }
        for (; c + 8 <= nc; c += 8) { float2 s[8];
#pragma unroll
            for (int j = 0; j < 8; ++j) s[j] = sp0[(size_t)(c + j) * 64];
#pragma unroll
            for (int j = 0; j < 8; ++j) { const float nr = pr * xr - pi * xi + s[j].x, ni = pr * xi + pi * xr + s[j].y; xr = nr; xi = ni; } }
        for (; c < nc; ++c) { const float2 s = sp0[(size_t)c * 64]; const float nr = pr * xr - pi * xi + s.x, ni = pr * xi + pi * xr + s.y; xr = nr; xi = ni; }
    }
    for (int q = 0; q < 4; ++q) {
        const int tok0 = cp * 128 + 32 * q;
        f32x16s Dt[4]; ssm_bu_mfma(Dt, af, P, tok0, g, lane);
#pragma unroll
        for (int sub = 0; sub < 2; ++sub) {
            LDS_WAIT();
            ssm_bu_store(Dt, bu, sub, lane);
            LDS_WAIT();
#pragma unroll 4
            for (int s = 0; s < 16; ++s) { const f32x2v b = *(const LAS f32x2v*)(bu + s * BU_PITCH + lane * 8); const float nr = are * xr - aim * xi + b.x, ni = are * xi + aim * xr + b.y; xr = nr; xi = ni;
                *(LAS unsigned*)(xs + s * 272 + lane * 4) = pk2(xr, xi); }
            LDS_WAIT();
            f32x4 acc = (f32x4){0.f, 0.f, 0.f, 0.f};
#pragma unroll
            for (int kk = 0; kk < 4; ++kk) { const sbf16x8 xf = *(const LAS sbf16x8*)(xs + fr * 272 + 64 * kk + 16 * fq); acc = __builtin_amdgcn_mfma_f32_16x16x32_bf16(cf[kk], xf, acc, 0, 0, 0); }
            const int tok = tok0 + 16 * sub + fr;
            const v2u ub = *(const v2u*)(P + (size_t)tok * PPITCH + O_U + g * 16 + 4 * fq);
            const float u0 = bf_lo(ub.x), u1 = bf_hi(ub.x), u2 = bf_lo(ub.y), u3 = bf_hi(ub.y);
            float o[4]; const float uu[4] = {u0, u1, u2, u3};
#pragma unroll
            for (int e = 0; e < 4; ++e) { const float y = acc[e] + dsk[e] * uu[e]; const float u2 = 1.5957691216057308f * (y + 0.044715f * y * y * y); o[e] = y * __builtin_amdgcn_rcpf(1.f + __expf(-u2)); }
            v2u w; w.x = pk2(o[0], o[1]); w.y = pk2(o[2], o[3]);
            __hip_atomic_store((unsigned long long*)(YG + (size_t)tok * 256 + g * 16 + 4 * fq), ((unsigned long long)w.y << 32) | (unsigned long long)w.x, __ATOMIC_RELAXED, __HIP_MEMORY_SCOPE_AGENT);
        }
    }
}


typedef short bf16x8 __attribute__((ext_vector_type(8)));
typedef short s16x4 __attribute__((ext_vector_type(4)));
typedef short v4i16_t __attribute__((ext_vector_type(4)));
typedef float f32x16 __attribute__((ext_vector_type(16)));
typedef float f32x2_t __attribute__((ext_vector_type(2))); typedef __bf16 bf16x2_t __attribute__((ext_vector_type(2)));
#define MFMA32(a, b, c) __builtin_amdgcn_mfma_f32_32x32x16_bf16((a), (b), (c), 0, 0, 0)
__device__ __forceinline__ unsigned cvtpk_s(float lo, float hi) { f32x2_t v = {lo, hi}; bf16x2_t b = __builtin_convertvector(v, bf16x2_t); return __builtin_bit_cast(unsigned, b); }
__device__ __forceinline__ s16x4 vtr(const LAS unsigned char* p) { return __builtin_bit_cast(s16x4, __builtin_amdgcn_ds_read_tr16_b64_v4i16((LAS v4i16_t*)p)); }
__device__ __forceinline__ bf16x8 pack_step(const f32x16& x, int s) {
    v4u p; p.x = cvtpk_s(x[8 * s], x[8 * s + 1]); p.y = cvtpk_s(x[8 * s + 2], x[8 * s + 3]); p.z = cvtpk_s(x[8 * s + 4], x[8 * s + 5]); p.w = cvtpk_s(x[8 * s + 6], x[8 * s + 7]);
    return __builtin_bit_cast(bf16x8, p);
}
__device__ __forceinline__ void load_kfrags(bf16x8 (&kf)[2][4], const bf16* __restrict__ kbase  , int r, int h) {
#pragma unroll
    for (int kb = 0; kb < 2; ++kb)
#pragma unroll
        for (int st = 0; st < 4; ++st) kf[kb][st] = *(const bf16x8*)(kbase + (size_t)(32 * kb + r) * PPITCH + 16 * st + 8 * h);
}
__device__ __forceinline__ void load_vregs(v4u (&vr)[8], const bf16* __restrict__ vbase, int lane) {
#pragma unroll
    for (int i = 0; i < 8; ++i) vr[i] = *(const v4u*)(vbase + (size_t)(i * 8 + (lane >> 3)) * PPITCH + (lane & 7) * 8);
}
__device__ __forceinline__ void store_vtile(const v4u (&vr)[8], LAS unsigned char* vt, int lane) {
    const int c = lane & 7;
#pragma unroll
    for (int i = 0; i < 8; ++i) *(LAS v4u*)(vt + (c >> 2) * 4096 + (i * 8 + (lane >> 3)) * 64 + (c & 3) * 16) = vr[i];
}
__device__ __forceinline__ void qk_tile(f32x16 (&x)[2], const bf16x8 (&kf)[2][4], const bf16x8 (&qf)[4]) {
#pragma unroll
    for (int kb = 0; kb < 2; ++kb) {
        f32x16 a;
#pragma unroll
        for (int i = 0; i < 16; ++i) a[i] = 0.f;
#pragma unroll
        for (int st = 0; st < 4; ++st) a = MFMA32(kf[kb][st], qf[st], a);
        x[kb] = a;
    }
}
__device__ __forceinline__ void pv_tile(f32x16 (&oT)[2], const f32x16 (&p)[2], const LAS unsigned char* vt, int lane) {
    const int i16 = lane & 15, q = i16 >> 2, pp = i16 & 3, blk = (lane >> 4) & 1, h = lane >> 5;
    const LAS unsigned char* vb = vt + (4 * h + q) * 64 + 8 * (4 * blk + pp);
#pragma unroll
    for (int kb = 0; kb < 2; ++kb)
#pragma unroll
        for (int s = 0; s < 2; ++s) {
            const bf16x8 xs = pack_step(p[kb], s);
#pragma unroll
            for (int dt = 0; dt < 2; ++dt) {
                const s16x4 lo = vtr(vb + dt * 4096 + (32 * kb + 16 * s) * 64), hi = vtr(vb + dt * 4096 + (32 * kb + 16 * s + 8) * 64);
                const bf16x8 pa = __builtin_shufflevector(lo, hi, 0, 1, 2, 3, 4, 5, 6, 7);
                oT[dt] = MFMA32(pa, xs, oT[dt]);
            }
        }
}
__device__ __forceinline__ void store_oT(const f32x16 (&oT)[2], float sc, bf16* __restrict__ orow  , int h, float* __restrict__ ssq_row  ) {
    float sq = 0.f;
#pragma unroll
    for (int dt = 0; dt < 2; ++dt)
#pragma unroll
        for (int g = 0; g < 4; ++g) { const float a = oT[dt][4 * g] * sc, b = oT[dt][4 * g + 1] * sc, c = oT[dt][4 * g + 2] * sc, d = oT[dt][4 * g + 3] * sc; sq += a * a + b * b + c * c + d * d;
            v2u w; w.x = cvtpk_s(a, b); w.y = cvtpk_s(c, d);
            *(v2u*)(orow + 32 * dt + 8 * g + 4 * h) = w; }
    sq += __shfl_xor(sq, 32);
    if (h == 0) *ssq_row = sq;
}

__device__ __forceinline__ void sb_task_mfma(const bf16* __restrict__ P, bf16* __restrict__ MIXRAW, float* __restrict__ ssq, LAS unsigned char* wl, int head, int q0, int lane) {
    const int r = lane & 31, h = lane >> 5;
    bf16x8 qf[4];
#pragma unroll
    for (int st = 0; st < 4; ++st) qf[st] = *(const bf16x8*)(P + (size_t)(q0 + r) * PPITCH + O_QSB + head * 64 + 16 * st + 8 * h);
    f32x16 oT[2];
#pragma unroll
    for (int i = 0; i < 16; ++i) { oT[0][i] = 0.f; oT[1][i] = 0.f; }
    float carry = 0.f;
    const int kt0 = q0 >> 6;
    for (int kt = kt0; kt >= 0; --kt) {
        bf16x8 kf[2][4]; v4u vr[8];
        load_kfrags(kf, P + (size_t)kt * 64 * PPITCH + O_KSB + head * 64, r, h);
        load_vregs(vr, P + (size_t)kt * 64 * PPITCH + O_VSB + head * 64, lane);
        f32x16 x[2];
        qk_tile(x, kf, qf);
        LDS_WAIT();
        store_vtile(vr, wl, lane);
        const bool diag = (kt == kt0);
        f32x16 ln[2];
#pragma unroll
        for (int kb = 0; kb < 2; ++kb)
#pragma unroll
            for (int i = 0; i < 16; ++i) {
                const float z = x[kb][i];
                float l = -(fmaxf(z, 0.f) + flog2(1.f + fexp2(-fabsf(z))));
                if (diag) { const int kpos = kt * 64 + 32 * kb + (i & 3) + 8 * (i >> 2) + 4 * h; l = (kpos < q0 + r) ? l : 0.f; }
                ln[kb][i] = l;
            }
        float Tm[8], Tp[8], suf[2][16];
#pragma unroll
        for (int kb = 0; kb < 2; ++kb)
#pragma unroll
            for (int g = 0; g < 4; ++g) {
                const float e0 = ln[kb][4 * g], e1 = ln[kb][4 * g + 1], e2 = ln[kb][4 * g + 2], e3 = ln[kb][4 * g + 3];
                suf[kb][4 * g + 3] = 0.f; suf[kb][4 * g + 2] = e3; suf[kb][4 * g + 1] = e3 + e2; suf[kb][4 * g] = e3 + e2 + e1;
                Tm[4 * kb + g] = (e3 + e2) + (e1 + e0);
            }
#pragma unroll
        for (int i = 0; i < 8; ++i) Tp[i] = __shfl_xor(Tm[i], 32);
        float R[8]; R[7] = 0.f;
#pragma unroll
        for (int i = 6; i >= 0; --i) R[i] = R[i + 1] + (Tm[i + 1] + Tp[i + 1]);
        const float tile_total = R[0] + (Tm[0] + Tp[0]);
        f32x16 w[2];
#pragma unroll
        for (int kb = 0; kb < 2; ++kb)
#pragma unroll
            for (int g = 0; g < 4; ++g) {
                const int gi = 4 * kb + g;
                const float off = carry + R[gi] + (h ? 0.f : Tp[gi]);
#pragma unroll
                for (int e = 0; e < 4; ++e) {
                    const int i = 4 * g + e;
                    float ww = fexp2(x[kb][i] + ln[kb][i] + (off + suf[kb][i]));
                    if (diag) { const int kpos = kt * 64 + 32 * kb + e + 8 * g + 4 * h; ww = (kpos < q0 + r) ? ww : 0.f; }
                    w[kb][i] = ww;
                }
            }
        carry += tile_total;
        pv_tile(oT, w, wl, lane);
        if (__all(carry < SB_STOP)) break;
    }
    store_oT(oT, 1.f, MIXRAW + (size_t)(q0 + r) * D + 256 + head * 64, h, ssq + (size_t)(q0 + r) * 4 + head);
}

__device__ __forceinline__ void ca_unit(const bf16* __restrict__ P, const float* __restrict__ rel_bias, bf16* __restrict__ MIXRAW, float* __restrict__ ssq, LAS unsigned char* sh, int head, int c0, int wave, int lane, int tid) {
    const int r = lane & 31, h = lane >> 5, ci = c0 + (wave >> 1), q0 = 64 * ci + 32 * (wave & 1);
    LAS unsigned char* Ks = sh; LAS unsigned char* Vs = sh + 16384; LAS float* bias_s = (LAS float*)(sh + 32768);
    __syncthreads();
    for (int i = tid; i < 320; i += NWAVES * 64) bias_s[i] = rel_bias[head * 257 + (i < 256 ? i : 256)] * LOG2E;
    bf16x8 qf[4];
#pragma unroll
    for (int st = 0; st < 4; ++st) qf[st] = *(const bf16x8*)(P + (size_t)(q0 + r) * PPITCH + O_QCA + head * 64 + 16 * st + 8 * h);
    f32x16 oT[2];
#pragma unroll
    for (int i = 0; i < 16; ++i) { oT[0][i] = 0.f; oT[1][i] = 0.f; }
    float m = -1e30f, l = 0.f;
    const int t0 = (c0 >= 8 ? c0 - 8 : 0), t1 = c0 + 3;
    const int srow = tid >> 3, sc = tid & 7;
    const int koff = srow * 128 + ((sc ^ (srow & 7)) << 4), voff = (sc >> 2) * 4096 + srow * 64 + (sc & 3) * 16;
    v4u kreg = *(const v4u*)(P + (size_t)(t0 * 64 + srow) * PPITCH + O_KCA + head * 64 + sc * 8);
    v4u vreg = *(const v4u*)(P + (size_t)(t0 * 64 + srow) * PPITCH + O_VCA + head * 64 + sc * 8);
    *(LAS v4u*)(Ks + koff) = kreg; *(LAS v4u*)(Vs + voff) = vreg;
    __syncthreads();
    const float bfar = bias_s[256];
    for (int t = t0; t <= t1; ++t) {
        const int cur = (t - t0) & 1;
        if (t < t1) { kreg = *(const v4u*)(P + (size_t)((t + 1) * 64 + srow) * PPITCH + O_KCA + head * 64 + sc * 8); vreg = *(const v4u*)(P + (size_t)((t + 1) * 64 + srow) * PPITCH + O_VCA + head * 64 + sc * 8); }
        if (t <= ci && t + 8 >= ci) {
            const LAS unsigned char* kb_ = Ks + cur * 8192;
            bf16x8 kf[2][4];
#pragma unroll
            for (int kb = 0; kb < 2; ++kb)
#pragma unroll
                for (int st = 0; st < 4; ++st) { const int row = 32 * kb + r; kf[kb][st] = *(const LAS bf16x8*)(kb_ + row * 128 + (((2 * st + h) ^ (row & 7)) << 4)); }
            f32x16 x[2];
            qk_tile(x, kf, qf);
            float badd = bfar;
            if (ci - t < 3) { badd = 0.f;
                const LAS float* bp = bias_s + ((q0 + r) - t * 64 - 4 * h + 128);
#pragma unroll
                for (int kb = 0; kb < 2; ++kb)
#pragma unroll
                    for (int i = 0; i < 16; ++i) x[kb][i] += bp[-(32 * kb + (i & 3) + 8 * (i >> 2))];
            }
            float tm = x[0][0];
#pragma unroll
            for (int kb = 0; kb < 2; ++kb)
#pragma unroll
                for (int i = 0; i < 16; ++i) tm = fmaxf(tm, x[kb][i]);
            tm = fmaxf(tm, __shfl_xor(tm, 32)) + badd;
            if (__any(tm > m)) {
                const float mn = fmaxf(m, tm), scl = fexp2(m - mn); m = mn; l *= scl;
#pragma unroll
                for (int i = 0; i < 16; ++i) { oT[0][i] *= scl; oT[1][i] *= scl; }
            }
            const float mm = m - badd; const f32x2v mm2 = {mm, mm}; f32x2v ps2 = {0.f, 0.f};
#pragma unroll
            for (int kb = 0; kb < 2; ++kb)
#pragma unroll
                for (int i = 0; i < 16; i += 2) { f32x2v v = {x[kb][i], x[kb][i + 1]}; v = v - mm2; f32x2v p; p.x = fexp2(v.x); p.y = fexp2(v.y); x[kb][i] = p.x; x[kb][i + 1] = p.y; ps2 = ps2 + p; }
            l += ps2.x + ps2.y;
            pv_tile(oT, x, Vs + cur * 8192, lane);
        }
        if (t < t1) { *(LAS v4u*)(Ks + (cur ^ 1) * 8192 + koff) = kreg; *(LAS v4u*)(Vs + (cur ^ 1) * 8192 + voff) = vreg; }
        __syncthreads();
    }
    l += __shfl_xor(l, 32);
    store_oT(oT, 1.f / l, MIXRAW + (size_t)(q0 + r) * D + 512 + head * 64, h, ssq + (size_t)(q0 + r) * 8 + head);
}
#define XB_TMO      128
#define XB_XCNT(j)  (256  + 64 * (j))
#define XB_XSUB(j)  (1280 + 64 * (j))
#define XB_XGEN(j)  (2304 + 64 * (j))
#define XB_TOP      3328
#define XB_TOPGEN   3392
#define XCD_BAR_WORDS 3456
#define XB_SPIN_CAP (1u << 18)

__device__ __forceinline__ unsigned xb_ld(unsigned* p)              { return __hip_atomic_load(p, __ATOMIC_RELAXED, __HIP_MEMORY_SCOPE_AGENT); }
__device__ __forceinline__ unsigned xb_add(unsigned* p, unsigned v) { return __hip_atomic_fetch_add(p, v, __ATOMIC_RELAXED, __HIP_MEMORY_SCOPE_AGENT); }
__device__ __forceinline__ unsigned xb_xcc_id() { return (unsigned)__builtin_amdgcn_s_getreg((3 << 11) | 20) & 0xFu; }
#define XB_SPIN(cond, bar) do { unsigned _sp = 0; while (cond) { __builtin_amdgcn_s_sleep(1); \
    if ((++_sp & 255u) == 0u) { if (xb_ld(&(bar)[XB_TMO])) break; if (_sp > XB_SPIN_CAP) { atomicAdd(&(bar)[XB_TMO], 1u); break; } } } } while (0)

struct XcdBarrier {
    int wv;
    unsigned* bar; unsigned x;
    volatile LAS unsigned* st;
};

__device__ __forceinline__ XcdBarrier xcd_barrier_post(unsigned* bar, volatile LAS unsigned* st) {
    XcdBarrier b; b.bar = bar; b.x = xb_xcc_id(); b.st = st;
    if (threadIdx.x == 0) (void)xb_add(&bar[XB_XCNT(b.x)], 1u);
    return b;
}
__device__ __forceinline__ void xcd_barrier_complete(unsigned* bar, unsigned x, unsigned& nloc, unsigned& nx) {
    const unsigned G = gridDim.x * gridDim.y * gridDim.z;
    unsigned sum, cnt, mine, sp = 0u;
    for (;;) {
        sum = 0u; cnt = 0u; mine = 0u;
#pragma unroll
        for (unsigned j = 0; j < 16; ++j) { const unsigned c = xb_ld(&bar[XB_XCNT(j)]); sum += c; cnt += (c > 0u) ? 1u : 0u; mine = (j == x) ? c : mine; }
        if (sum == G) break;
        __builtin_amdgcn_s_sleep(1);
        if ((++sp & 255u) == 0u) { if (xb_ld(&bar[XB_TMO])) break; if (sp > XB_SPIN_CAP) { atomicAdd(&bar[XB_TMO], 1u); break; } }
    }
    nloc = mine > 0u ? mine : 1u; nx = cnt > 0u ? cnt : 1u;
}

__device__ __forceinline__ void xcd_barrier(const XcdBarrier& b) {
    asm volatile("s_waitcnt vmcnt(0)" ::: "memory");
    __syncthreads();
    if (b.wv == 0 && __builtin_amdgcn_mbcnt_hi(~0u, __builtin_amdgcn_mbcnt_lo(~0u, 0u)) == 0u) {
        unsigned* bar = b.bar;
        __builtin_amdgcn_s_waitcnt(0);
        unsigned nloc = b.st[0], nx = b.st[1];
        if (nloc == 0u) { xcd_barrier_complete(bar, b.x, nloc, nx); b.st[0] = nloc; b.st[1] = nx; }
        const unsigned old = xb_add(&bar[XB_XSUB(b.x)], 1u);
        const unsigned gen = old / nloc;
        if (old + 1u == (gen + 1u) * nloc) {
            __builtin_amdgcn_fence(__ATOMIC_RELEASE, "agent");
            asm volatile("s_waitcnt vmcnt(0)" ::: "memory");
            const unsigned og = xb_add(&bar[XB_TOP], 1u);
            const unsigned tg = og / nx;
            if (og + 1u == (tg + 1u) * nx) xb_add(&bar[XB_TOPGEN], 1u);
            else XB_SPIN(xb_ld(&bar[XB_TOPGEN]) == tg, bar);
            __builtin_amdgcn_fence(__ATOMIC_ACQUIRE, "agent");
            xb_add(&bar[XB_XGEN(b.x)], 1u);
            asm volatile("s_waitcnt vmcnt(0)" ::: "memory");
        } else {
            XB_SPIN(xb_ld(&bar[XB_XGEN(b.x)]) == gen, bar);
            __builtin_amdgcn_fence(__ATOMIC_ACQUIRE, "agent");
            asm volatile("s_waitcnt vmcnt(0)" ::: "memory");
        }
    }
    __syncthreads();
}

typedef const Args __attribute__((address_space(4)))* CArgs;
#define LARGS() ({ CArgs p_ = (CArgs)__builtin_amdgcn_kernarg_segment_ptr(); asm volatile("" : "+s"(p_)); p_; })
#define LINT(x) ({ int v_ = (x); asm volatile("" : "+s"(v_)); v_; })

#define PH_BEGIN(kind)
#define PH_END(kind)
#define SEAM() do { if (ONE_LAUNCH) { XcdBarrier b_ = bar; asm volatile("" : "+s"(b_.bar)); xcd_barrier(b_); } } while (0)
#define IN(k) ({ CArgs a_ = LARGS(); const int k_ = (k); a_->ph_lo <= k_ && k_ < a_->ph_hi; })
#define PTID() ({ int t_; asm volatile("v_mbcnt_lo_u32_b32 %0, -1, 0\n\tv_mbcnt_hi_u32_b32 %0, -1, %0" : "=v"(t_)); wave_s * 64 + t_; })
#define FILL_SHORT(units, budget) do { const int u_ = (units) % (int)gridDim.x; if (u_ != 0) { WAVE_IDS(); conv_fill(LARGS(), cvc, u_, (budget), (LAS float*)wl, wave, lane); } } while (0)
#define DRAIN(req) do { conv_drain(LARGS(), cvc, (req), (LAS float*)wl, wave, lane); } while (0)
#define RS_PREPASS(So, ss16) do { const int tid_ = PTID(); LAS float* rt_ = (LAS float*)(lds + RS_OFF); \
    for (int i_ = 0; i_ < 12; ++i_) { const long L_ = (long)i_ * (So).G + (So).c; if (L_ >= (So).nwg) break; pg8::Unit u_; (So).unit_of((int)L_, u_); \
        if (tid_ < 256) { const float* p_ = (ss16) + ((size_t)u_.pm * 256 + tid_) * 16; rt_[i_ * 256 + tid_] = rsqrtf(pg8::sum16f(p_) * (1.f / D) + 1e-6f); } } \
    __syncthreads(); } while (0)
#define WAVE_IDS() const int tid = PTID(), lane = tid & 63, wave = wave_s; const int G = gridDim.x, bx = blockIdx.x; const int gw = bx * NWAVES + wave, NGW = G * NWAVES; LAS unsigned char* wl = lds + wave * WAVE_LDS; (void)wl; (void)gw; (void)NGW; (void)lane; (void)G; (void)bx

template <int lraw> __device__ __forceinline__ void layer_body(LAS unsigned char* lds, const XcdBarrier& bar, const int wave_s, int& cvc) {
    constexpr bool MOE = (lraw & 1) != 0;
    constexpr int CVB_NEXT = lraw == 0 ? CV_B1 : (lraw == 1 ? CV_B2 : (lraw == 2 ? CV_B3 : CV_M3));
    if (!MOE) if (IN(1 + lraw * PH_PER_LAYER + 0)) { PH_BEGIN(1);
        WAVE_IDS(); CArgs A = LARGS(); unsigned char* ws = A->ws;
        row_phase(lraw == 0 ? A->in[0] : A->out, A->out, lraw != 0, lraw == 0 ? nullptr : (const bf16*)(ws + WS_R2), (const bf16*)(ws + WS_Y2), (const int*)(ws + WS_CTL) + CW_MOE + 0 * MOE_WORDS + 256, (const int*)(ws + WS_TOKSLOT), (const float*)(ws + WS_TOKG), (bf16*)(ws + WS_H), (float*)(ws + SS_A), gw, NGW, lane);
        DRAIN(lraw == 0 ? CV_B0 : CV_B2);
        SEAM(); PH_END(1);
    }
    if (IN(1 + lraw * PH_PER_LAYER + 1)) { PH_BEGIN(2);
        CArgs A = LARGS(); const int l = LINT(lraw); unsigned char* ws = A->ws;
        pg8::Gemm g{(const bf16*)(ws + WS_H), (const bf16*)(ws + WS_WIN + l * WIN_BYTES), S, DPROJ, D, nullptr, 0, PTID()}; pg8::StaticOrder So; So.init(S, DPROJ, gridDim.x, blockIdx.x, WGM_INPROJ);
        pg8::EpiInProj E{(bf16*)(ws + WS_PROJ), A->in[3] + l * 64, A->in[4] + l * 64, A->in[5] + l * 64, A->in[6] + l * 64, QSCALE, (const LAS float*)(lds + RS_OFF), PPITCH};
        RS_PREPASS(So, (const float*)(ws + SS_A));
        pg8::gemm_phase<pg8::EpiInProj, pg8::StaticOrder, true, true>(lds, g, So, E);
        FILL_SHORT((S / 256) * (DPROJ / 256), FILL_B1);
        SEAM(); PH_END(2);
    }
    if (IN(1 + lraw * PH_PER_LAYER + 2)) { PH_BEGIN(3);
        WAVE_IDS(); CArgs A = LARGS(); const int l = LINT(lraw); unsigned char* ws = A->ws;
        const bf16* PROJ = (const bf16*)(ws + WS_PROJ); bf16* MIXRAW = (bf16*)(ws + WS_MIXRAW);
        SsmPar sp{A->in[8] + l * 1024, A->in[9] + l * 1024, A->in[10] + l * 16, A->in[11] + (size_t)l * 16384, A->in[12] + (size_t)l * 16384, A->in[13] + (size_t)l * 16384, A->in[14] + (size_t)l * 16384, A->in[15] + l * 256};
        unsigned* flag = (unsigned*)(ws + WS_CTL) + CW_SSMF + 64 * l;
        for (int t = gw; t < 2048; t += NGW) ssm_a2_task(PROJ, (const float2*)(ws + TAB_A), (const bf16*)(ws + TAB_B), (float2*)(ws + WS_SEND), wl, l * 16 + (t & 15), t & 15, t >> 4, lane);
        asm volatile("s_waitcnt vmcnt(0)" ::: "memory");
        __syncthreads();
        if (wave == 0 && lane == 0) xb_add(flag, 1u);
        for (int t = gw; t < 2048; t += NGW) sb_task_mfma(PROJ, MIXRAW, (float*)(ws + SSQ_SB), wl, t & 3, 32 * (t >> 2), lane);
        __syncthreads();
        if (G == 256) { const int v = bx >> 3; ca_unit(PROJ, A->in[7] + (size_t)l * 8 * 257, MIXRAW, (float*)(ws + SSQ_CA), lds, v & 7, 32 * (bx & 7) + 4 * (v >> 3), wave, lane, tid); }
        __syncthreads();
        { unsigned sp_ = 0; while (xb_ld(flag) < (unsigned)G) { __builtin_amdgcn_s_sleep(2); if (++sp_ > (1u << 22)) break; } }
        asm volatile("" ::: "memory");
        for (int t = gw; t < 2048; t += NGW) ssm_c2_task(PROJ, sp, (const float2*)(ws + TAB_A), (const bf16*)(ws + TAB_B), (const float2*)(ws + WS_SEND), (bf16*)(ws + WS_YG), wl, l * 16 + (t & 15), t & 15, t >> 4, lane);
        asm volatile("s_waitcnt vmcnt(0)" ::: "memory");
        __syncthreads();
        if (wave == 0 && lane == 0) xb_add(flag + 32, 1u);
        if (G == 256) { const int v = 32 + (bx >> 3); ca_unit(PROJ, A->in[7] + (size_t)l * 8 * 257, MIXRAW, (float*)(ws + SSQ_CA), lds, v & 7, 32 * (bx & 7) + 4 * (v >> 3), wave, lane, tid); }
        __syncthreads();
        { unsigned sp_ = 0; while (xb_ld(flag + 32) < (unsigned)G) { __builtin_amdgcn_s_sleep(2); if (++sp_ > (1u << 22)) break; } }
        asm volatile("" ::: "memory");
        { CArgs A2 = LARGS(); unsigned char* ws2 = A2->ws;
          pg8::Gemm g{(const bf16*)(ws2 + WS_YG), (const bf16*)(ws2 + WS_WGLU + l * WGLU_BYTES), S, 512, 256, nullptr, 0, PTID()}; pg8::StaticOrder So; So.init(S, 512, gridDim.x, blockIdx.x, WGM_GLU);
          pg8::EpiGated<0> E{(bf16*)(ws2 + WS_MIXRAW), D, 0, nullptr, (float*)(ws2 + SSQ_SSM), nullptr};
          pg8::gemm_phase<pg8::EpiGated<0>, pg8::StaticOrder, true, true>(lds, g, So, E); }
        FILL_SHORT((S / 256) * 2, FILL_GLU);
        SEAM(); PH_END(3);
    }
    if (IN(1 + lraw * PH_PER_LAYER + 6)) { PH_BEGIN(7);
        CArgs A = LARGS(); const int l = LINT(lraw); unsigned char* ws = A->ws;
        pg8::Gemm g{(const bf16*)(ws + WS_MIXRAW), (const bf16*)(ws + WS_WOUT + l * WOUT_BYTES), S, D, D, nullptr, 0, PTID()}; pg8::StaticOrder So; So.init(S, D, gridDim.x, blockIdx.x, WGM_OUT);
        LAS float* fac = (LAS float*)(lds + MISC_OFF + 256);
        { pg8::Unit u0; const int tid = PTID(); if (So.first_unit(u0) && tid < 256) {
              const size_t row = (size_t)u0.pm * 256 + tid;
              const float rs = rsqrtf(pg8::sum8f((const float*)(ws + SSQ_SSM) + row * 8) * (1.f / 256.f) + 1e-6f), rb = rsqrtf(pg8::sum4f((const float*)(ws + SSQ_SB) + row * 4) * (1.f / 256.f) + 1e-6f),
                          rc = rsqrtf(pg8::sum8f((const float*)(ws + SSQ_CA) + row * 8) * (1.f / 512.f) + 1e-6f);
              fac[tid] = rs / rb; fac[256 + tid] = rb / rc; fac[512 + tid] = rc; }
          __syncthreads(); }
        pg8::EpiResidual<true> E{A->out, lraw == 0 ? A->in[0] : A->out, D, 1.f, (bf16*)(ws + WS_H), (float*)(ws + SS_B), fac};
        pg8::gemm_phase<pg8::EpiResidual<true>, pg8::StaticOrder, true, true>(lds, g, So, E);
        if (!MOE) { WAVE_IDS(); DRAIN(lraw == 0 ? CV_F0 : CV_F1); }
        SEAM(); PH_END(7);
    }
    if (!MOE) {
        if (IN(1 + lraw * PH_PER_LAYER + 8)) { PH_BEGIN(10);
            CArgs A = LARGS(); const int l = LINT(lraw); unsigned char* ws = A->ws; const int fidx = l >> 1;
            pg8::Gemm g{(const bf16*)(ws + WS_H), (const bf16*)(ws + WS_GU + fidx * GU_BYTES), S, 2 * DFF, D, nullptr, 0, PTID()}; pg8::StaticOrder So; So.init(S, 2 * DFF, gridDim.x, blockIdx.x, WGM_GUD);
            pg8::EpiGated<1, 2> E{(bf16*)(ws + WS_R1), DFF, 0, nullptr, nullptr, (const LAS float*)(lds + RS_OFF)};
            RS_PREPASS(So, (const float*)(ws + SS_B));
            pg8::gemm_phase<pg8::EpiGated<1, 2>, pg8::StaticOrder, true, true>(lds, g, So, E);
            FILL_SHORT((S / 256) * (2 * DFF / 256), FILL_B1);
            SEAM(); PH_END(10);
        }
        if (IN(1 + lraw * PH_PER_LAYER + 9)) { PH_BEGIN(11);
            CArgs A = LARGS(); const int l = LINT(lraw); unsigned char* ws = A->ws; const int fidx = l >> 1;
            pg8::Gemm g{(const bf16*)(ws + WS_R1), (const bf16*)(ws + WS_DN + fidx * DN_BYTES), S, D, DFF, nullptr, 0, PTID()}; pg8::StaticOrder So; So.init(S, D, gridDim.x, blockIdx.x, WGM_DND);
            pg8::EpiResidual<false> E{A->out, A->out, D, 1.f, (bf16*)(ws + WS_H), (float*)(ws + SS_A), nullptr};
            pg8::gemm_phase<pg8::EpiResidual<false>, pg8::StaticOrder, true, true>(lds, g, So, E);
            { WAVE_IDS(); DRAIN(CVB_NEXT); }
            SEAM(); PH_END(11);
        }
    } else {
        if (IN(1 + lraw * PH_PER_LAYER + 7)) { PH_BEGIN(9);
            WAVE_IDS(); CArgs A = LARGS(); const int l = LINT(lraw); unsigned char* ws = A->ws;
            int r_row, r_e0, r_e1, r_p0, r_p1; float r_r;
            route_phase(A->out, A->in[19] + (size_t)l * D, A->in[23] + (size_t)(l >> 1) * D * 8, (int*)(ws + WS_CTL) + CW_WGCNT, (float*)(ws + WS_TOKG), gw, NGW, lane, (LAS float*)lds, tid, r_row, r_e0, r_e1, r_p0, r_p1, r_r);
            unsigned* flag = (unsigned*)(ws + WS_CTL) + CW_SSMF + 64 * l + 16;
            asm volatile("s_waitcnt vmcnt(0)" ::: "memory");
            __syncthreads();
            if (wave == 0 && lane == 0) xb_add(flag, 1u);
            DRAIN(lraw == 1 ? CV_M1 : CV_M3);
            { unsigned sp_ = 0; while (xb_ld(flag) < (unsigned)G) { __builtin_amdgcn_s_sleep(2); if (++sp_ > (1u << 22)) break; } }
            asm volatile("" ::: "memory");
            { CArgs A2 = LARGS(); unsigned char* ws2 = A2->ws;
              perm_phase((int*)(ws2 + WS_CTL) + CW_MOE + (l >> 1) * MOE_WORDS, (const int*)(ws2 + WS_CTL) + CW_WGCNT, (int*)(ws2 + WS_TOKSLOT), (int*)(ws2 + WS_SLOTTOK), (float*)(ws2 + SLOT_RS), (LAS int*)lds, gw, lane, tid, r_row, r_e0, r_e1, r_p0, r_p1, r_r); }
            SEAM(); PH_END(9);
        }
        if (IN(1 + lraw * PH_PER_LAYER + 9)) { PH_BEGIN(13);
            CArgs A = LARGS(); const int l = LINT(lraw); unsigned char* ws = A->ws; const int fidx = 2 + NEXP * (l >> 1);
            const int* mctl = (const int*)(ws + WS_CTL) + CW_MOE + (l >> 1) * MOE_WORDS; const int nt = mctl[16];
            pg8::Gemm g{(const bf16*)(ws + WS_H), (const bf16*)(ws + WS_GU + fidx * GU_BYTES), nt * 256, 2 * DFF, D, mctl + 32, GU_BYTES, PTID(), 0, (const int*)(ws + WS_SLOTTOK)}; pg8::StaticOrder So; So.init(nt * 256, 2 * DFF, gridDim.x, blockIdx.x, WGM_GUM);
            pg8::EpiGated<1, 1> E{(bf16*)(ws + WS_R1), DFF, 0, (const float*)(ws + SLOT_RS), nullptr, nullptr};
            pg8::gemm_phase<pg8::EpiGated<1, 1>, pg8::StaticOrder, true, true>(lds, g, So, E);
            FILL_SHORT(nt * (2 * DFF / 256), FILL_B1);
            SEAM(); PH_END(13);
        }
        if (IN(1 + lraw * PH_PER_LAYER + 10)) { PH_BEGIN(14);
            CArgs A = LARGS(); const int l = LINT(lraw); unsigned char* ws = A->ws; const int fidx = 2 + NEXP * (l >> 1);
            const int* mctl = (const int*)(ws + WS_CTL) + CW_MOE + (l >> 1) * MOE_WORDS; const int nt = mctl[16];
            pg8::Gemm g{(const bf16*)(ws + WS_R1), (const bf16*)(ws + WS_DN + fidx * DN_BYTES), nt * 256, D, DFF, mctl + 32, DN_BYTES, PTID()}; pg8::StaticOrder So; So.init(nt * 256, D, gridDim.x, blockIdx.x, WGM_DNM);
            pg8::EpiStoreBf16 E{(bf16*)(ws + WS_R2), D, (bf16*)(ws + WS_Y2)};
            const int units = nt * (D / 256);
            if (gridDim.x == 256 && units > 512) {
                So.limit = 512;
                pg8::gemm_phase<pg8::EpiStoreBf16, pg8::StaticOrder, true, true>(lds, g, So, E);
                pg8::LeftoverOrder Lo; Lo.init(nt * 256, D, gridDim.x, blockIdx.x, 512, WGM_DNM); pg8::Gemm g2 = g; g2.Klen = DFF / 2; g2.tid = PTID();
                pg8::gemm_phase<pg8::EpiStoreBf16, pg8::LeftoverOrder, true, true>(lds, g2, Lo, E);
                if (lraw == 1) { FILL_SHORT(2 * (units - 512) < 256 ? 2 * (units - 512) : 0, FILL_MDN2); }
            } else {
                pg8::gemm_phase<pg8::EpiStoreBf16, pg8::StaticOrder, true, true>(lds, g, So, E);
                if (lraw == 1) { FILL_SHORT(units, FILL_MDN); }
            }
            if (lraw == 1) { WAVE_IDS(); DRAIN(CVB_NEXT); }
            SEAM(); PH_END(14);
        }
    }
}

__global__ void __launch_bounds__(NWAVES * 64, 2) mk_fwd(Args args_unused) {
    extern __shared__ __attribute__((aligned(16))) unsigned char lds_raw[];
    LAS unsigned char* lds = (LAS unsigned char*)lds_raw;
    volatile LAS unsigned* MISC = (volatile LAS unsigned*)(lds + MISC_OFF);
    if (threadIdx.x < 32) MISC[threadIdx.x] = 0u;
    __syncthreads();
    const int wave_s = __builtin_amdgcn_readfirstlane(threadIdx.x >> 6);
    XcdBarrier bar; { CArgs A = LARGS(); bar.bar = (unsigned*)(A->ws + WS_CTL) + CW_BAR; bar.x = 0; bar.st = nullptr; if (ONE_LAUNCH) bar = xcd_barrier_post((unsigned*)(A->ws + WS_CTL) + CW_BAR, MISC + 8); bar.wv = wave_s; }
    int cvc = 0;
    if (IN(0)) { PH_BEGIN(0); WAVE_IDS(); CArgs A = LARGS(); conv_drain(A, cvc, CV_B0, (LAS float*)wl, wave, lane);
        if (gw < 64) { const int l = gw >> 4, g = gw & 15; unsigned char* ws = A->ws;
            SsmPar sp{A->in[8] + l * 1024, A->in[9] + l * 1024, A->in[10] + l * 16, A->in[11] + (size_t)l * 16384, A->in[12] + (size_t)l * 16384, A->in[13] + (size_t)l * 16384, A->in[14] + (size_t)l * 16384, A->in[15] + l * 256};
            ssm_table_task(sp, (float2*)(ws + TAB_A), (bf16*)(ws + TAB_B), gw, g, lane); } PH_END(0); }

    layer_body<0>(lds, bar, wave_s, cvc); layer_body<1>(lds, bar, wave_s, cvc); layer_body<2>(lds, bar, wave_s, cvc); layer_body<3>(lds, bar, wave_s, cvc);
    if (IN(N_PHASES - 1)) { WAVE_IDS(); CArgs A = LARGS(); unsigned char* ws = A->ws;
        row_phase(A->out, A->out, true, (const bf16*)(ws + WS_R2), (const bf16*)(ws + WS_Y2), (const int*)(ws + WS_CTL) + CW_MOE + 1 * MOE_WORDS + 256, (const int*)(ws + WS_TOKSLOT), (const float*)(ws + WS_TOKG), nullptr, nullptr, gw, NGW, lane); }
#undef IN
#undef SEAM
}

extern "C" void kernel_launch(void* const* d_in, const int* in_sizes, int n_in, void* d_out, int out_size, void* d_ws, size_t ws_size, hipStream_t stream) {
    static int grid = 0;
    if (grid == 0) {
        if (n_in != 27 || out_size != S * D || ws_size < WS_END) { fprintf(stderr, "kernel_launch: unexpected problem (n_in %d, out %d, ws %zu)\n", n_in, out_size, ws_size); grid = -1; return; }
        int dev = 0, cus = 0, per_cu = 0;
        if (hipGetDevice(&dev) != hipSuccess || hipDeviceGetAttribute(&cus, hipDeviceAttributeMultiprocessorCount, dev) != hipSuccess) { grid = -1; return; }
        if (hipFuncSetAttribute((const void*)mk_fwd, hipFuncAttributeMaxDynamicSharedMemorySize, LDS_BYTES) != hipSuccess) { fprintf(stderr, "kernel_launch: hipFuncSetAttribute failed\n"); grid = -1; return; }
        if (hipOccupancyMaxActiveBlocksPerMultiprocessor(&per_cu, (const void*)mk_fwd, NWAVES * 64, LDS_BYTES) != hipSuccess || per_cu < 1) { fprintf(stderr, "kernel_launch: occupancy query says %d\n", per_cu); }
        (void)hipGetLastError();
        if (cus < 256 || per_cu < 1) { fprintf(stderr, "kernel_launch: needs 256 CUs with one resident 512-thread workgroup each (have %d CUs, %d per CU)\n", cus, per_cu); grid = -1; return; }
        grid = 256;
    }
    if (grid < 0) return;
    if (hipMemsetAsync((char*)d_ws + WS_CTL, 0, CTL_ZERO_BYTES, stream) != hipSuccess) return;
    Args a{};
    for (int i = 0; i < 27; ++i) a.in[i] = (const float*)d_in[i];
    a.out = (float*)d_out; a.ws = (unsigned char*)d_ws;
    if (ONE_LAUNCH) {
        a.ph_lo = 0; a.ph_hi = N_PHASES;
        hipLaunchKernelGGL(mk_fwd, dim3(grid), dim3(NWAVES * 64), LDS_BYTES, stream, a);
    } else {
        for (int p = 0; p < N_PHASES; ++p) {
            if (p >= 1 && p < N_PHASES - 1) { const int l = (p - 1) / PH_PER_LAYER, k = (p - 1) % PH_PER_LAYER; const bool moe = l & 1;
                if (k == 5 || (k == 0 && moe) || (k == 7 && !moe) || (k == 10 && !moe)) continue; }
            a.ph_lo = p; a.ph_hi = p + 1;
            hipLaunchKernelGGL(mk_fwd, dim3(grid), dim3(NWAVES * 64), LDS_BYTES, stream, a);
        }
    }
}
```

```cpp
#include <hip/hip_runtime.h>
#include <cstdio>
#include <cstdint>
namespace pg8 {
#define PG8_LAS __attribute__((address_space(3)))
typedef unsigned short bf16_t;
typedef short bf16x8 __attribute__((ext_vector_type(8)));
typedef float f32x4 __attribute__((ext_vector_type(4)));
typedef unsigned u32x4 __attribute__((ext_vector_type(4)));
constexpr int BM = 256, BK = 64, HALF = 128, HTB = HALF * BK * 2  , STAGE_BYTES = 8 * HTB, NXCD = 8, WGM_DEFAULT = 4;

__host__ __device__ __forceinline__ int lds_byte(int r, int c) { const int st = (r >> 4) * 2 + (c >> 5), rr = r & 15, cc = c & 31, ob = rr * 64 + cc * 2; return st * 1024 + (ob ^ (((ob >> 9) & 1) << 5)); }
__host__ __device__ __forceinline__ void stage_rc(int b, int& R, int& C) { const int st = b / 1024, sb = b % 1024, swz = sb ^ (((sb >> 9) & 1) << 5); R = (st >> 1) * 16 + swz / 64; C = (st & 1) * 32 + (swz % 64) / 2; }
__host__ __device__ __forceinline__ int perm32(int rho) { const int n = rho >> 4, i = rho & 15; return 8 * (i >> 2) + 4 * n + (i & 3); }

struct Unit { int pm, pn, half, ord; };
struct Gemm { const bf16_t* A; const bf16_t* Bt; int M, N, K; const int* tile_e; size_t estride; int tid; int Klen; const int* gidx; };

struct StaticOrder {
    int nM, nN, nwg, G, c, limit, WGM;
    __host__ __device__ void init(int M, int N, int G_, int c_, int wgm = WGM_DEFAULT) { nM = M / BM; nN = N / BM; nwg = nM * nN; G = G_; c = c_; limit = nwg; WGM = wgm; }
    __host__ __device__ bool next(int i, Unit& u) const {
        const long L = (long)i * G + c; if (L >= limit) return false; u.half = 0; u.ord = i;
        int wgid = (int)L; { const int q = nwg / NXCD, r = nwg % NXCD, xcd = wgid % NXCD, off = wgid / NXCD; wgid = (xcd < r ? xcd * (q + 1) : r * (q + 1) + (xcd - r) * q) + off; }
        const int nig = WGM * nN, gid = wgid / nig, fm = gid * WGM, gsz = (nM - fm) < WGM ? (nM - fm) : WGM;
        u.pm = fm + ((wgid % nig) % gsz); u.pn = (wgid % nig) / gsz; return true;
    }
    __device__ __forceinline__ bool first_unit(Unit& u) const {
        if (c >= nwg) return false; u.half = 0; u.ord = 0;
        int wgid = c; { const int q = nwg / NXCD, r = nwg % NXCD, xcd = wgid % NXCD, off = wgid / NXCD; wgid = (xcd < r ? xcd * (q + 1) : r * (q + 1) + (xcd - r) * q) + off; }
        const int nig = WGM * nN, gid = wgid / nig, fm = gid * WGM, gsz = (nM - fm) < WGM ? (nM - fm) : WGM;
        u.pm = fm + ((wgid % nig) % gsz); u.pn = (wgid % nig) / gsz; return true;
    }
    __device__ __forceinline__ void a_ready(const Unit&) const {}
    __device__ __forceinline__ void done(const Unit&) const {}
    __host__ __device__ __forceinline__ void unit_of(int L, Unit& u) const {
        int wgid = L; { const int q = nwg / NXCD, r = nwg % NXCD, xcd = wgid % NXCD, off = wgid / NXCD; wgid = (xcd < r ? xcd * (q + 1) : r * (q + 1) + (xcd - r) * q) + off; }
        const int nig = WGM * nN, gid = wgid / nig, fm = gid * WGM, gsz = (nM - fm) < WGM ? (nM - fm) : WGM;
        u.pm = fm + ((wgid % nig) % gsz); u.pn = (wgid % nig) / gsz;
    }
};
struct LeftoverOrder {
    StaticOrder so; int base;
    __host__ __device__ void init(int M, int N, int G_, int c_, int base_, int wgm = WGM_DEFAULT) { so.init(M, N, G_, c_, wgm); base = base_; }
    __host__ __device__ bool next(int i, Unit& u) const {
        const int j = i * so.G + so.c; if (j >= 2 * (so.nwg - base)) return false;
        so.unit_of(base + (j >> 1), u); u.half = j & 1; u.ord = i; return true;
    }
    __device__ __forceinline__ void a_ready(const Unit&) const {}
    __device__ __forceinline__ void done(const Unit&) const {}
};

__device__ __forceinline__ unsigned cvt_pk_bf16(float lo, float hi) { unsigned r; asm volatile("v_cvt_pk_bf16_f32 %0, %1, %2" : "=v"(r) : "v"(lo), "v"(hi)); return r; }
__device__ __forceinline__ u32x4 pack8(const f32x4& a, const f32x4& b) { u32x4 w; w.x = cvt_pk_bf16(a[0], a[1]); w.y = cvt_pk_bf16(a[2], a[3]); w.z = cvt_pk_bf16(b[0], b[1]); w.w = cvt_pk_bf16(b[2], b[3]); return w; }

__device__ __forceinline__ float sum4f(const float* p) { const f32x4 a = *(const f32x4*)p; return (a[0] + a[1]) + (a[2] + a[3]); }
__device__ __forceinline__ float sum8f(const float* p) { return sum4f(p) + sum4f(p + 4); }
__device__ __forceinline__ float sum16f(const float* p) { return sum8f(p) + sum8f(p + 8); }
__device__ __forceinline__ float row_sum16(const float* base16, int fq) { float s = sum4f(base16 + 4 * fq); s += __shfl_xor(s, 16); s += __shfl_xor(s, 32); return s; }
__device__ __forceinline__ void rows_rstd16(float (&r)[2][4], const float* ss16, int row0  , int fq) {
    f32x4 pv[2][4];
#pragma unroll
    for (int ai = 0; ai < 2; ++ai)
#pragma unroll
        for (int m = 0; m < 4; ++m) pv[ai][m] = *(const f32x4*)(ss16 + (size_t)(row0 + ai * HALF + m * 16) * 16 + 4 * fq);
#pragma unroll
    for (int ai = 0; ai < 2; ++ai)
#pragma unroll
        for (int m = 0; m < 4; ++m) { float s = (pv[ai][m][0] + pv[ai][m][1]) + (pv[ai][m][2] + pv[ai][m][3]); s += __shfl_xor(s, 16); s += __shfl_xor(s, 32); r[ai][m] = rsqrtf(s * (1.f / 1024.f) + 1e-6f); }
}
struct EpiInProj {
    static constexpr bool PERM = true, AFTER_DRAIN = false;
    static constexpr bool KHOOK = false, GATHER = false;
    bf16_t* P; const float *gq_sb, *gk_sb, *gq_ca, *gk_ca; float qscale; const PG8_LAS float* rs_lds; int ppitch;
    __device__ __forceinline__ void operator()(const f32x4 (&acc)[2][2][4][2], const Unit& u, int wr, int wc, int fr, int fq) const {
        const int pn = u.pn; const float* g = nullptr; float gs = 1.f;
        if (pn == 0) { g = gq_sb; gs = qscale; } else if (pn == 1) { g = gk_sb; } else if (pn == 3 || pn == 4) { g = gq_ca; gs = qscale; } else if (pn == 5 || pn == 6) { g = gk_ca; }
        bf16_t* base = P + (size_t)(u.pm * BM + wr * 64 + fr) * ppitch + pn * 256 + wc * 64 + fq * 8;
        float r0s[2][4];
#pragma unroll
        for (int ai = 0; ai < 2; ++ai)
#pragma unroll
            for (int m = 0; m < 4; ++m) r0s[ai][m] = rs_lds[u.ord * 256 + ai * HALF + wr * 64 + m * 16 + fr];
        if (g) {
            f32x4 gv[2][2];
#pragma unroll
            for (int bj = 0; bj < 2; ++bj)
#pragma unroll
                for (int n = 0; n < 2; ++n) gv[bj][n] = *(const f32x4*)(g + 32 * bj + 8 * fq + 4 * n) * gs;
#pragma unroll
            for (int ai = 0; ai < 2; ++ai)
#pragma unroll
                for (int m = 0; m < 4; ++m) {
                    const float r0 = r0s[ai][m];
                    float ss = 0.f;
#pragma unroll
                    for (int bj = 0; bj < 2; ++bj)
#pragma unroll
                        for (int n = 0; n < 2; ++n) { const f32x4 v = acc[ai][bj][m][n]; ss += v[0] * v[0] + v[1] * v[1] + v[2] * v[2] + v[3] * v[3]; }
                    ss += __shfl_xor(ss, 16); ss += __shfl_xor(ss, 32);
                    const float r = r0 * rsqrtf(ss * (r0 * r0) * (1.f / 64.f) + 1e-6f);
                    bf16_t* rowp = base + (size_t)(ai * HALF + m * 16) * ppitch;
#pragma unroll
                    for (int bj = 0; bj < 2; ++bj) *(u32x4*)(rowp + bj * 32) = pack8(acc[ai][bj][m][0] * r * gv[bj][0], acc[ai][bj][m][1] * r * gv[bj][1]);
                }
        } else {
#pragma unroll
            for (int ai = 0; ai < 2; ++ai)
#pragma unroll
                for (int m = 0; m < 4; ++m) { bf16_t* rowp = base + (size_t)(ai * HALF + m * 16) * ppitch;
                    const float r0 = r0s[ai][m];
#pragma unroll
                    for (int bj = 0; bj < 2; ++bj) *(u32x4*)(rowp + bj * 32) = pack8(acc[ai][bj][m][0] * r0, acc[ai][bj][m][1] * r0); }
        }
    }
};
template <int KIND, int RSMODE = 0> struct EpiGated {
    static constexpr bool PERM = true, AFTER_DRAIN = false, KHOOK = false, GATHER = (KIND == 1 && RSMODE == 1);
    bf16_t* O; int ldc; int col0; const float* rs; float* ssq; const PG8_LAS float* rs_lds;
    __device__ __forceinline__ void operator()(const f32x4 (&acc)[2][2][4][2], const Unit& u, int wr, int wc, int fr, int fq) const {
        float rrs[2][4];
        if (KIND == 1) { if (RSMODE == 0) rows_rstd16(rrs, rs, u.pm * BM + wr * 64 + fr, fq); else if (RSMODE == 2) {
#pragma unroll
            for (int ai = 0; ai < 2; ++ai)
#pragma unroll
                for (int m = 0; m < 4; ++m) rrs[ai][m] = rs_lds[u.ord * 256 + ai * HALF + wr * 64 + m * 16 + fr]; } else {
#pragma unroll
            for (int ai = 0; ai < 2; ++ai)
#pragma unroll
                for (int m = 0; m < 4; ++m) rrs[ai][m] = rs[u.pm * BM + ai * HALF + wr * 64 + m * 16 + fr]; } }
#pragma unroll
        for (int ai = 0; ai < 2; ++ai)
#pragma unroll
            for (int m = 0; m < 4; ++m) {
                const int row = u.pm * BM + ai * HALF + wr * 64 + m * 16 + fr;
                float rr = 1.f;
                if (KIND == 1) rr = rrs[ai][m];
                f32x4 r[2]; float sq = 0.f;
#pragma unroll
                for (int n = 0; n < 2; ++n)
#pragma unroll
                    for (int e = 0; e < 4; ++e) { const float a = acc[ai][0][m][n][e] * rr, b = acc[ai][1][m][n][e] * rr;
                        const float o = (KIND == 0) ? a * __builtin_amdgcn_rcpf(1.f + __expf(-b)) : a * __builtin_amdgcn_rcpf(1.f + __expf(-a)) * b; r[n][e] = o; sq += o * o; }
                *(u32x4*)(O + (size_t)row * ldc + col0 + u.pn * 128 + wc * 32 + fq * 8) = pack8(r[0], r[1]);
                if (KIND == 0) { sq += __shfl_xor(sq, 16); sq += __shfl_xor(sq, 32); if (fq == 0) ssq[(size_t)row * 8 + u.pn * 4 + wc] = sq; }
            }
    }
};
template <bool HOOKED> struct EpiResidual {
    static constexpr bool PERM = true, AFTER_DRAIN = false, KHOOK = HOOKED, GATHER = false;
    float* X; const float* Xsrc; int ldc; float scale; bf16_t* XB; float* ss_out; const PG8_LAS float* fac;
    __device__ __forceinline__ void khook(int t, f32x4 (&acc)[2][2][4][2], const Unit& u, int wr, int fr) const {
        if (t != 4 && t != 8) return;
        const PG8_LAS float* fp = fac + (t == 4 ? 0 : 256) + wr * 64 + fr;
#pragma unroll
        for (int ai = 0; ai < 2; ++ai)
#pragma unroll
            for (int m = 0; m < 4; ++m) {
                const float f = fp[ai * HALF + m * 16];
#pragma unroll
                for (int bj = 0; bj < 2; ++bj)
#pragma unroll
                    for (int n = 0; n < 2; ++n) acc[ai][bj][m][n] = acc[ai][bj][m][n] * f;
            }
    }
    __device__ __forceinline__ void operator()(const f32x4 (&acc)[2][2][4][2], const Unit& u, int wr, int wc, int fr, int fq) const {
#pragma unroll
        for (int ai = 0; ai < 2; ++ai)
#pragma unroll
            for (int m = 0; m < 4; ++m) {
                const int row = u.pm * BM + ai * HALF + wr * 64 + m * 16 + fr;
                float sc = scale; if (HOOKED) sc *= fac[512 + ai * HALF + wr * 64 + m * 16 + fr];
                float sq = 0.f;
#pragma unroll
                for (int bj = 0; bj < 2; ++bj) { const size_t off = (size_t)row * ldc + u.pn * BM + bj * HALF + wc * 32 + fq * 8; f32x4* p = (f32x4*)(X + off); const f32x4* ps = (const f32x4*)(Xsrc + off);
                    const f32x4 a = ps[0] + acc[ai][bj][m][0] * sc, b = ps[1] + acc[ai][bj][m][1] * sc; p[0] = a; p[1] = b;
                    *(u32x4*)(XB + off) = pack8(a, b);
                    sq += a[0] * a[0] + a[1] * a[1] + a[2] * a[2] + a[3] * a[3] + b[0] * b[0] + b[1] * b[1] + b[2] * b[2] + b[3] * b[3]; }
                sq += __shfl_xor(sq, 16); sq += __shfl_xor(sq, 32);
                if (fq == 0) ss_out[(size_t)row * 16 + u.pn * 4 + wc] = sq;
            }
    }
};
struct EpiStoreBf16 {
    static constexpr bool PERM = true, AFTER_DRAIN = false, KHOOK = false, GATHER = false;
    bf16_t* O; int ldc; bf16_t* O2;
    __device__ __forceinline__ void operator()(const f32x4 (&acc)[2][2][4][2], const Unit& u, int wr, int wc, int fr, int fq) const {
        bf16_t* Ob = u.half ? O2 : O;
#pragma unroll
        for (int ai = 0; ai < 2; ++ai)
#pragma unroll
            for (int m = 0; m < 4; ++m) {
                const int row = u.pm * BM + ai * HALF + wr * 64 + m * 16 + fr;
#pragma unroll
                for (int bj = 0; bj < 2; ++bj) *(u32x4*)(Ob + (size_t)row * ldc + u.pn * BM + bj * HALF + wc * 32 + fq * 8) = pack8(acc[ai][bj][m][0], acc[ai][bj][m][1]);
            }
    }
};
template <class Epi, class Sched, bool ALIGN_EPI = false, bool SP2 = false>
__device__ __forceinline__ void gemm_phase(PG8_LAS unsigned char* lds, const Gemm g, const Sched& S, const Epi& E) {
    int tid_ = g.tid; asm volatile("" : "+v"(tid_));
    const int tid = tid_, wid = __builtin_amdgcn_readfirstlane(tid >> 6), lane = tid & 63, wr = wid >> 2, wc = wid & 3, fr = lane & 15, fq = lane >> 4;
    const int K = g.K, klen = g.Klen ? g.Klen : g.K, nt = klen / BK;
    const size_t hoff = (size_t)klen * 2;
    unsigned voffA[2], voffB[2];
#pragma unroll
    for (int i = 0; i < 2; ++i) { int R, C; stage_rc(tid * 16 + i * 8192, R, C); const int Rb = Epi::PERM ? ((R & ~31) + perm32(R & 31)) : R;
        voffA[i] = (unsigned)(R * K + C) * 2u; voffB[i] = (unsigned)(Rb * K + C) * 2u; }
    constexpr bool GA = Epi::GATHER; static_assert(!GA || SP2, "gather is wired into the SP2 loop only");
    unsigned vc0[2] = {0u, 0u}, vc1[2] = {0u, 0u}, vn0[2] = {0u, 0u}, vn1[2] = {0u, 0u};
#define PG8_GOFF(d0, d1, pm_) do { _Pragma("unroll") for (int _i = 0; _i < 2; ++_i) { int R_, C_; stage_rc(tid * 16 + _i * 8192, R_, C_); const int* gp_ = g.gidx + (pm_) * 256 + R_; \
        d0[_i] = ((unsigned)gp_[0] * (unsigned)K + (unsigned)C_) * 2u; d1[_i] = ((unsigned)gp_[HALF] * (unsigned)K + (unsigned)C_) * 2u; } } while (0)
    const size_t kstep = (size_t)(BK * 2);
    const size_t hstep = (size_t)HALF * K * 2;
    const size_t tstep = 2 * hstep;
    const unsigned ldsw = (unsigned)wid * 1024u;
    const int aoff = lds_byte(wr * 64 + fr, fq * 8), boff = lds_byte(wc * 32 + fr, fq * 8);
#define PG8_SA(b, h) (((b) * 2 + (h)) * HTB)
#define PG8_SB(b, h) ((4 + (b) * 2 + (h)) * HTB)
#define PG8_STAGE(bufoff, gbase, voff) do { _Pragma("unroll") for (int _i = 0; _i < 2; ++_i) \
        __builtin_amdgcn_global_load_lds((const unsigned*)((const char*)(gbase) + (voff)[_i]), (PG8_LAS unsigned*)(lds + (bufoff) + ldsw + _i * 8192), 16, 0, 0); } while (0)
#define PG8_LDA(dst, b, h) do { _Pragma("unroll") for (int m = 0; m < 4; ++m) _Pragma("unroll") for (int k = 0; k < 2; ++k) dst[m][k] = *(const PG8_LAS bf16x8*)(lds + PG8_SA(b, h) + aoff + m * 2048 + k * 1024); } while (0)
#define PG8_LDB(dst, b, h) do { _Pragma("unroll") for (int n = 0; n < 2; ++n) _Pragma("unroll") for (int k = 0; k < 2; ++k) dst[n][k] = *(const PG8_LAS bf16x8*)(lds + PG8_SB(b, h) + boff + n * 2048 + k * 1024); } while (0)
#define PG8_MMA(ai, bj, At, Bt) do { __builtin_amdgcn_s_setprio(1); _Pragma("unroll") for (int m = 0; m < 4; ++m) _Pragma("unroll") for (int n = 0; n < 2; ++n) _Pragma("unroll") for (int k = 0; k < 2; ++k) \
        acc[ai][bj][m][n] = __builtin_amdgcn_mfma_f32_16x16x32_bf16(Bt[n][k], At[m][k], acc[ai][bj][m][n], 0, 0, 0); __builtin_amdgcn_s_setprio(0); } while (0)
#define PG8_WAIT_V(n) asm volatile("s_waitcnt vmcnt(" #n ")" ::: "memory")
#define PG8_WAIT_L(n) asm volatile("s_waitcnt lgkmcnt(" #n ")" ::: "memory")
#define PG8_BAR __builtin_amdgcn_s_barrier()
#define PG8_SCHED __builtin_amdgcn_sched_barrier(0)
    Unit cur, nxt; int ui = 0;
    if (!S.next(0, cur)) return;
    f32x4 acc[2][2][4][2];
#pragma unroll
    for (int a = 0; a < 2; ++a)
#pragma unroll
        for (int b = 0; b < 2; ++b)
#pragma unroll
            for (int m = 0; m < 4; ++m)
#pragma unroll
                for (int n = 0; n < 2; ++n) acc[a][b][m][n] = (f32x4){0.f, 0.f, 0.f, 0.f};
    bf16x8 At[4][2], B0[2][2], B1[2][2];
    const char* cA = (const char*)g.A + (GA ? (size_t)0 : (size_t)cur.pm * tstep) + cur.half * hoff;
    if constexpr (GA) PG8_GOFF(vc0, vc1, cur.pm);
    const char* cB = (const char*)g.Bt + (g.tile_e ? (size_t)g.tile_e[cur.pm] * g.estride : (size_t)0) + (size_t)cur.pn * tstep + cur.half * hoff;
    S.a_ready(cur);
    if constexpr (SP2) {
        PG8_STAGE(PG8_SB(0, 0), cB, voffB); PG8_STAGE(PG8_SB(0, 1), cB + hstep, voffB);
        if constexpr (GA) { PG8_STAGE(PG8_SA(0, 0), cA, vc0); PG8_STAGE(PG8_SA(0, 1), cA, vc1); } else { PG8_STAGE(PG8_SA(0, 0), cA, voffA); PG8_STAGE(PG8_SA(0, 1), cA + hstep, voffA); }
        if (wr == 1) PG8_BAR;
        PG8_WAIT_V(2); PG8_BAR;
        PG8_STAGE(PG8_SB(1, 0), cB + kstep, voffB); if constexpr (GA) PG8_STAGE(PG8_SA(1, 0), cA + kstep, vc0); else PG8_STAGE(PG8_SA(1, 0), cA + kstep, voffA); PG8_STAGE(PG8_SB(1, 1), cB + hstep + kstep, voffB);
        PG8_WAIT_V(6); PG8_BAR;
    } else {
        PG8_STAGE(PG8_SB(0, 0), cB, voffB); PG8_STAGE(PG8_SA(0, 0), cA, voffA); PG8_STAGE(PG8_SB(0, 1), cB + hstep, voffB); PG8_STAGE(PG8_SA(0, 1), cA + hstep, voffA);
        if (wr == 1) PG8_BAR;
        PG8_WAIT_V(4); PG8_BAR;
        PG8_STAGE(PG8_SB(1, 0), cB + kstep, voffB); PG8_STAGE(PG8_SA(1, 0), cA + kstep, voffA); PG8_STAGE(PG8_SB(1, 1), cB + hstep + kstep, voffB);
        PG8_WAIT_V(6); PG8_BAR;
    }
    for (;;) {
        const bool has_next = S.next(ui + 1, nxt);
        if constexpr (GA) { if (has_next) PG8_GOFF(vn0, vn1, nxt.pm); else { vn0[0] = vc0[0]; vn0[1] = vc0[1]; vn1[0] = vc1[0]; vn1[1] = vc1[1]; } }
        const char* nA = has_next ? (const char*)g.A + (GA ? (size_t)0 : (size_t)nxt.pm * tstep) + nxt.half * hoff : cA; const char* nB = has_next ? (const char*)g.Bt + (g.tile_e ? (size_t)g.tile_e[nxt.pm] * g.estride : (size_t)0) + (size_t)nxt.pn * tstep + nxt.half * hoff : cB;
        for (int t = 0; t < nt; t += 2) {
            if constexpr (Epi::KHOOK) E.khook(t, acc, cur, wr, fr);
            const bool last = (t == nt - 2);
            const char* a1 = cA + (size_t)(t + 1) * kstep;
            const char* a2 = last ? nA : cA + (size_t)(t + 2) * kstep; const char* b2 = last ? nB : cB + (size_t)(t + 2) * kstep;
            const char* a3 = a2 + kstep; const char* b3 = b2 + kstep;
            if (last && has_next) S.a_ready(nxt);
            if constexpr (SP2) {
            unsigned va0[2], va1[2];
            if constexpr (GA) { va0[0] = last ? vn0[0] : vc0[0]; va0[1] = last ? vn0[1] : vc0[1]; va1[0] = last ? vn1[0] : vc1[0]; va1[1] = last ? vn1[1] : vc1[1]; }
            PG8_LDB(B0, 0, 0); PG8_LDB(B1, 0, 1); PG8_SCHED; PG8_LDA(At, 0, 0); if constexpr (GA) PG8_STAGE(PG8_SA(1, 1), a1, vc1); else PG8_STAGE(PG8_SA(1, 1), a1 + hstep, voffA);
            PG8_WAIT_V(8); PG8_WAIT_L(0); PG8_BAR; PG8_MMA(0, 0, At, B0); PG8_MMA(0, 1, At, B1); PG8_BAR; PG8_SCHED;
            PG8_LDA(At, 0, 1); PG8_STAGE(PG8_SB(0, 0), b2, voffB); PG8_STAGE(PG8_SB(0, 1), b2 + hstep, voffB); if constexpr (GA) PG8_STAGE(PG8_SA(0, 0), a2, va0); else PG8_STAGE(PG8_SA(0, 0), a2, voffA);
            PG8_WAIT_V(8); PG8_WAIT_L(0); PG8_BAR; PG8_MMA(1, 0, At, B0); PG8_MMA(1, 1, At, B1); PG8_BAR; PG8_SCHED;
            PG8_LDB(B0, 1, 0); PG8_LDB(B1, 1, 1); PG8_SCHED; PG8_LDA(At, 1, 0); if constexpr (GA) PG8_STAGE(PG8_SA(0, 1), a2, va1); else PG8_STAGE(PG8_SA(0, 1), a2 + hstep, voffA);
            PG8_WAIT_V(8); PG8_WAIT_L(0); PG8_BAR; PG8_MMA(0, 0, At, B0); PG8_MMA(0, 1, At, B1); PG8_BAR; PG8_SCHED;
            PG8_LDA(At, 1, 1); PG8_STAGE(PG8_SB(1, 0), b3, voffB); PG8_STAGE(PG8_SB(1, 1), b3 + hstep, voffB); if constexpr (GA) PG8_STAGE(PG8_SA(1, 0), a3, va0); else PG8_STAGE(PG8_SA(1, 0), a3, voffA);
            PG8_WAIT_V(8); PG8_WAIT_L(0); PG8_BAR; PG8_MMA(1, 0, At, B0); PG8_MMA(1, 1, At, B1); PG8_BAR; PG8_SCHED;
            } else {
            PG8_LDB(B0, 0, 0); PG8_SCHED; PG8_LDA(At, 0, 0); PG8_STAGE(PG8_SA(1, 1), a1 + hstep, voffA);
            PG8_WAIT_L(8); PG8_BAR; PG8_WAIT_L(0); PG8_MMA(0, 0, At, B0); PG8_BAR; PG8_SCHED;
            PG8_LDB(B1, 0, 1); PG8_STAGE(PG8_SB(0, 0), b2, voffB);
            PG8_BAR; PG8_WAIT_L(0); PG8_MMA(0, 1, At, B1); PG8_BAR;
            PG8_LDA(At, 0, 1); PG8_STAGE(PG8_SA(0, 0), a2, voffA);
            PG8_BAR; PG8_WAIT_L(0); PG8_MMA(1, 0, At, B0); PG8_BAR; PG8_SCHED;
            PG8_STAGE(PG8_SB(0, 1), b2 + hstep, voffB);
            PG8_WAIT_V(6); PG8_BAR; PG8_MMA(1, 1, At, B1); PG8_BAR;
            PG8_LDB(B0, 1, 0); PG8_SCHED; PG8_LDA(At, 1, 0); PG8_STAGE(PG8_SA(0, 1), a2 + hstep, voffA);
            PG8_WAIT_L(8); PG8_BAR; PG8_WAIT_L(0); PG8_MMA(0, 0, At, B0); PG8_BAR; PG8_SCHED;
            PG8_LDB(B1, 1, 1); PG8_STAGE(PG8_SB(1, 0), b3, voffB);
            PG8_BAR; PG8_WAIT_L(0); PG8_MMA(0, 1, At, B1); PG8_BAR;
            PG8_LDA(At, 1, 1); PG8_STAGE(PG8_SA(1, 0), a3, voffA);
            PG8_BAR; PG8_WAIT_L(0); PG8_MMA(1, 0, At, B0); PG8_BAR; PG8_SCHED;
            PG8_STAGE(PG8_SB(1, 1), b3 + hstep, voffB);
            PG8_WAIT_V(6); PG8_BAR; PG8_MMA(1, 1, At, B1); PG8_BAR;
            }
        }
        if constexpr (ALIGN_EPI) { if (wr == 0) PG8_BAR; }
        if constexpr (!Epi::AFTER_DRAIN) { E(acc, cur, wr, wc, fr, fq); S.done(cur); }
        if (!has_next) break;
#pragma unroll
        for (int a = 0; a < 2; ++a)
#pragma unroll
            for (int b = 0; b < 2; ++b)
#pragma unroll
                for (int m = 0; m < 4; ++m)
#pragma unroll
                    for (int n = 0; n < 2; ++n) acc[a][b][m][n] = (f32x4){0.f, 0.f, 0.f, 0.f};
        cur = nxt; cA = nA; cB = nB; ++ui;
        if constexpr (GA) { vc0[0] = vn0[0]; vc0[1] = vn0[1]; vc1[0] = vn1[0]; vc1[1] = vn1[1]; }
        if constexpr (ALIGN_EPI) { if (wr == 1) PG8_BAR; }
    }
    PG8_WAIT_V(0);
    if constexpr (!ALIGN_EPI) { if (wr == 0) PG8_BAR; }
    PG8_BAR;
    if constexpr (Epi::AFTER_DRAIN) { E.fused(acc, cur, wr, wc, fr, fq, lds, wid, lane); S.done(cur); }
#undef PG8_SA
#undef PG8_SB
#undef PG8_STAGE
#undef PG8_GOFF
#undef PG8_LDA
#undef PG8_LDB
#undef PG8_MMA
#undef PG8_WAIT_V
#undef PG8_WAIT_L
#undef PG8_BAR
#undef PG8_SCHED
}
}

constexpr int S = 16384, D = 1024, DEPTH = 4, DPROJ = 2560, DFF = 2816, NEXP = 8;
#ifndef PPITCH_V
#define PPITCH_V 2688
#endif
constexpr int PPITCH = PPITCH_V;
constexpr int O_QSB = 0, O_KSB = 256, O_VSB = 512, O_QCA = 768, O_KCA = 1280, O_VCA = 1792, O_U = 2304;
constexpr int NWAVES = 8;
constexpr float LOG2E = 1.4426950408889634f;
constexpr float QSCALE = 0.125f * LOG2E;
constexpr float SB_STOP = -40.f;
#ifndef WGM_INPROJ
#define WGM_INPROJ 4
#endif
#ifndef WGM_GLU
#define WGM_GLU 4
#endif
#ifndef WGM_OUT
#define WGM_OUT 4
#endif
#ifndef WGM_DND
#define WGM_DND 4
#endif
#ifndef WGM_GUD
#define WGM_GUD 4
#endif
#ifndef WGM_GUM
#define WGM_GUM 4
#endif
#ifndef WGM_DNM
#define WGM_DNM 4
#endif
#ifndef FILL_B1
#define FILL_B1 8
#endif
#ifndef FILL_GLU
#define FILL_GLU 4
#endif
#ifndef FILL_MDN2
#define FILL_MDN2 0
#endif
#ifndef FILL_MDN
#define FILL_MDN 20
#endif
#ifndef MK_ONE_LAUNCH
#define MK_ONE_LAUNCH 1
#endif
constexpr bool ONE_LAUNCH = MK_ONE_LAUNCH;
constexpr int PH_PER_LAYER = 11, N_PHASES = 1 + DEPTH * PH_PER_LAYER + 1;

constexpr size_t MiB = 1u << 20;
constexpr size_t WS_CTL = 0, CTL_ZERO_BYTES = 1 * MiB;
constexpr size_t WS_TOKE = 1 * MiB, WS_TOKPOS = WS_TOKE + 128 * 1024, WS_TOKG = WS_TOKPOS + 128 * 1024, WS_TOKSLOT = WS_TOKG + 128 * 1024;
constexpr size_t WS_SEND = 2 * MiB;
constexpr size_t WS_SLOTTOK = 3 * MiB;
constexpr size_t WS_WIN = 4 * MiB, WIN_BYTES = (size_t)DPROJ * D * 2;
constexpr size_t WS_WGLU = 24 * MiB, WGLU_BYTES = 512 * 256 * 2;
constexpr size_t WS_WOUT = 25 * MiB, WOUT_BYTES = (size_t)D * D * 2;
constexpr size_t WS_GU = 33 * MiB, GU_BYTES = (size_t)2 * DFF * D * 2;
constexpr size_t WS_DN = 231 * MiB, DN_BYTES = (size_t)D * DFF * 2;
constexpr size_t WS_H = 330 * MiB;
constexpr size_t WS_R1 = 362 * MiB;
constexpr size_t WS_PROJ = WS_R1, WS_MIXRAW = WS_R1 + 96 * MiB, WS_MIXN = WS_R1 + 128 * MiB, WS_YG = WS_R1 + 160 * MiB;
static_assert((size_t)16384 * PPITCH * 2 <= 96 * MiB, "PROJ fits its slot");
constexpr size_t WS_R2 = 549 * MiB;
constexpr size_t WS_SS = 617 * MiB;
constexpr size_t SS_A = WS_SS, SS_B = WS_SS + 1 * MiB, SSQ_SSM = WS_SS + 2 * MiB, SSQ_SB = SSQ_SSM + 512 * 1024, SSQ_CA = SSQ_SB + 256 * 1024, RSTD_TOK = SSQ_CA + 512 * 1024, SLOT_RS = RSTD_TOK + 64 * 1024, RSTD_A = SLOT_RS + 192 * 1024, RSTD_B = RSTD_A + 64 * 1024;
constexpr size_t WS_TAB = 621 * MiB;
constexpr size_t TAB_A = WS_TAB, TAB_B = WS_TAB + 65536;
constexpr size_t WS_Y2 = 622 * MiB;
constexpr size_t WS_END = 690 * MiB;
constexpr int MAXTILES = 136;
constexpr int CW_SSMF = 8192;
constexpr int CW_BAR = 4096;
constexpr int CW_WGCNT = 20480;
constexpr int CW_MOE = 16384, MOE_WORDS = 1024;

constexpr int WAVE_LDS = 17920;
constexpr int MISC_OFF = 8 * WAVE_LDS;
constexpr int RS_OFF = 131072;
constexpr int LDS_BYTES = 147456;

#define GAS __attribute__((address_space(1)))
#define LAS __attribute__((address_space(3)))
typedef unsigned short bf16;
typedef unsigned v4u __attribute__((ext_vector_type(4)));
typedef unsigned v2u __attribute__((ext_vector_type(2)));
typedef float f32x4 __attribute__((ext_vector_type(4)));
#define LDS_WAIT() asm volatile("s_waitcnt lgkmcnt(0)" ::: "memory")
#define VM_WAIT() asm volatile("s_waitcnt vmcnt(0)" ::: "memory")
__device__ __forceinline__ float bf_lo(unsigned u) { return __builtin_bit_cast(float, u << 16); }
__device__ __forceinline__ float bf_hi(unsigned u) { return __builtin_bit_cast(float, u & 0xffff0000u); }
__device__ __forceinline__ unsigned pk2(float lo, float hi) { return pg8::cvt_pk_bf16(lo, hi); }
__device__ __forceinline__ float wave_sum(float v) {
#pragma unroll
    for (int o = 1; o < 64; o <<= 1) v += __shfl_xor(v, o);
    return v;
}
__device__ __forceinline__ float fexp2(float x) { return __builtin_amdgcn_exp2f(x); }
__device__ __forceinline__ float flog2(float x) { return __builtin_amdgcn_logf(x); }

struct Args { const float* in[27]; float* out; unsigned char* ws; int ph_lo, ph_hi; };

__device__ __forceinline__ void conv_item(const float* __restrict__ W, int K, int N, bf16* __restrict__ WT, int mode, LAS float* scr, int item, int lane, const float* __restrict__ gk = nullptr, bool kperm = false) {
    const int nblk = N / 32, kb = item / nblk, nb = item % nblk, k0 = 64 * kb, n0 = 32 * nb;
    const int c = lane & 7;
    f32x4 g0 = (f32x4){1.f, 1.f, 1.f, 1.f}, g1 = g0;
    if (gk) { g0 = *(const f32x4*)(gk + k0 + 8 * c); g1 = *(const f32x4*)(gk + k0 + 8 * c + 4); }
    float wv[32];
#pragma unroll
    for (int i = 0; i < 32; ++i) wv[i] = W[(size_t)(k0 + 2 * i + (lane >> 5)) * N + n0 + (lane & 31)];
#pragma unroll
    for (int i = 0; i < 32; ++i) scr[(2 * i + (lane >> 5)) * 33 + (lane & 31)] = wv[i];
    LDS_WAIT();
    int r0 = n0;
    if (mode == 1) { const int pn = n0 >> 8, nl = n0 & 255; r0 = 256 * pn + 128 * ((nl >> 5) & 1) + 32 * (nl >> 6); }
    else if (mode == 2) { const int hi = n0 >= 256, nn = n0 & 255; r0 = 256 * (nn >> 7) + 128 * hi + (nn & 127); }
    else if (mode == 3) { r0 = 256 * (n0 >> 7) + (n0 & 127); }
    else if (mode == 4) { r0 = 256 * (n0 >> 7) + 128 + (n0 & 127); }
    const int kd0 = kperm ? (k0 >= 768 ? k0 - 768 : k0 + 256) : k0;
#pragma unroll
    for (int j = 0; j < 4; ++j) { const int n = (lane >> 3) + 8 * j; const LAS float* s = scr + (8 * c) * 33 + n;
        v4u o; o.x = pk2(s[0 * 33] * g0[0], s[1 * 33] * g0[1]); o.y = pk2(s[2 * 33] * g0[2], s[3 * 33] * g0[3]); o.z = pk2(s[4 * 33] * g1[0], s[5 * 33] * g1[1]); o.w = pk2(s[6 * 33] * g1[2], s[7 * 33] * g1[3]);
        *(v4u*)(WT + (size_t)(r0 + n) * K + kd0 + 8 * c) = o; }
    LDS_WAIT();
}
constexpr int IT_IN = (D / 64) * (DPROJ / 32), IT_GLU = (256 / 64) * (512 / 32), IT_OUT = (D / 64) * (D / 32), IT_FF = (D / 64) * (DFF / 32);
static_assert(IT_FF == (DFF / 64) * (D / 32), "gate/up and down have the same item count");
constexpr int IT_B = IT_IN + IT_GLU + IT_OUT, IT_F = 3 * IT_FF, IT_M = NEXP * IT_F;
constexpr int CV_B0 = IT_B, CV_F0 = CV_B0 + IT_F, CV_B1 = CV_F0 + IT_B, CV_M1 = CV_B1 + IT_M, CV_B2 = CV_M1 + IT_B, CV_F1 = CV_B2 + IT_F, CV_B3 = CV_F1 + IT_B, CV_M3 = CV_B3 + IT_M, NIT_TOTAL = CV_M3;
typedef const Args __attribute__((address_space(4)))* CArgsP;
__device__ __forceinline__ void conv_B(CArgsP ap, int l, int r, LAS float* scr, int lane) {
    unsigned char* ws = ap->ws;
    if (r < IT_IN) conv_item(ap->in[2] + (size_t)l * D * DPROJ, D, DPROJ, (bf16*)(ws + WS_WIN + l * WIN_BYTES), 1, scr, r, lane, ap->in[1] + (size_t)l * D);
    else if (r < IT_IN + IT_GLU) conv_item(ap->in[16] + (size_t)l * 256 * 512, 256, 512, (bf16*)(ws + WS_WGLU + l * WGLU_BYTES), 2, scr, r - IT_IN, lane);
    else conv_item(ap->in[18] + (size_t)l * D * D, D, D, (bf16*)(ws + WS_WOUT + l * WOUT_BYTES), 0, scr, r - IT_IN - IT_GLU, lane, ap->in[17] + (size_t)l * D, true);
}
__device__ __forceinline__ void conv_F(CArgsP ap, int f, int r, LAS float* scr, int lane) {
    unsigned char* ws = ap->ws;
    const int which = r / IT_FF, idx = r % IT_FF; const size_t mo = (size_t)(f < 2 ? f : f - 2) * D * DFF;
    const float* gk = ap->in[19] + (size_t)(f < 2 ? 2 * f : (f < 10 ? 1 : 3)) * D;
    if (which == 0) conv_item((f < 2 ? ap->in[20] : ap->in[24]) + mo, D, DFF, (bf16*)(ws + WS_GU + f * GU_BYTES), 3, scr, idx, lane, gk);
    else if (which == 1) conv_item((f < 2 ? ap->in[21] : ap->in[25]) + mo, D, DFF, (bf16*)(ws + WS_GU + f * GU_BYTES), 4, scr, idx, lane, gk);
    else conv_item((f < 2 ? ap->in[22] : ap->in[26]) + mo, DFF, D, (bf16*)(ws + WS_DN + f * DN_BYTES), 0, scr, idx, lane);
}
__device__ __forceinline__ void conv_one(CArgsP ap, int it, LAS float* scr, int lane) {
    int r = it;
    if (r < CV_B0) { conv_B(ap, 0, r, scr, lane); return; } r -= IT_B;
    if (r < IT_F) { conv_F(ap, 0, r, scr, lane); return; } r -= IT_F;
    if (r < IT_B) { conv_B(ap, 1, r, scr, lane); return; } r -= IT_B;
    if (r < IT_M) { conv_F(ap, 2 + r / IT_F, r % IT_F, scr, lane); return; } r -= IT_M;
    if (r < IT_B) { conv_B(ap, 2, r, scr, lane); return; } r -= IT_B;
    if (r < IT_F) { conv_F(ap, 1, r, scr, lane); return; } r -= IT_F;
    if (r < IT_B) { conv_B(ap, 3, r, scr, lane); return; } r -= IT_B;
    conv_F(ap, 10 + r / IT_F, r % IT_F, scr, lane);
}
__device__ __forceinline__ void conv_fill(CArgsP ap, int& cvc, int first_cu, int budget, LAS float* scr, int wave, int lane) {
    const int G = gridDim.x, bx = blockIdx.x, nsw = (G - first_cu) * NWAVES, n = nsw * budget;
    int b = cvc + n; if (b > NIT_TOTAL) b = NIT_TOTAL;
    if (bx >= first_cu) for (int it = cvc + (bx - first_cu) * NWAVES + wave; it < b; it += nsw) conv_one(ap, it, scr, lane);
    cvc = b;
}
__device__ __forceinline__ void conv_drain(CArgsP ap, int& cvc, int required, LAS float* scr, int wave, int lane) {
    if (cvc >= required) return;
    const int nsw = gridDim.x * NWAVES;
    for (int it = cvc + blockIdx.x * NWAVES + wave; it < required; it += nsw) conv_one(ap, it, scr, lane);
    cvc = required;
}

__device__ __forceinline__ void row_phase(const float* __restrict__ xsrc, float* __restrict__ X, bool writeX, const bf16* __restrict__ Y, const bf16* __restrict__ Y2, const int* __restrict__ split, const int* __restrict__ tok_slot, const float* __restrict__ tok_g,
                                          bf16* __restrict__ XB, float* __restrict__ rstd_out, int gw, int NGW, int lane, float oscale = 1.f) {
    for (int row0 = gw; row0 < S; row0 += 2 * NGW) {
        const bool two = row0 + NGW < S;
        f32x4 v[2][4]; int s0[2], s1[2]; float g0[2], g1[2];
#pragma unroll
        for (int j = 0; j < 2; ++j) { const int row = (j == 0 || two) ? row0 + j * NGW : row0;
#pragma unroll
            for (int i = 0; i < 4; ++i) v[j][i] = *(const f32x4*)(xsrc + (size_t)row * D + 4 * lane + 256 * i);
            if (Y) { s0[j] = tok_slot[2 * row]; s1[j] = tok_slot[2 * row + 1]; g0[j] = tok_g[2 * row]; g1[j] = tok_g[2 * row + 1]; } }
        if (Y) {
            v2u a[2][4], b[2][4]; int k0[2], k1[2];
#pragma unroll
            for (int j = 0; j < 2; ++j) {
#pragma unroll
                for (int i = 0; i < 4; ++i) { a[j][i] = *(const v2u*)(Y + (size_t)s0[j] * D + 4 * lane + 256 * i); b[j][i] = *(const v2u*)(Y + (size_t)s1[j] * D + 4 * lane + 256 * i); }
                k0[j] = split[s0[j] >> 8]; k1[j] = split[s1[j] >> 8]; }
#pragma unroll
            for (int j = 0; j < 2; ++j) {
#pragma unroll
                for (int i = 0; i < 4; ++i) { v[j][i][0] += g0[j] * bf_lo(a[j][i].x) + g1[j] * bf_lo(b[j][i].x); v[j][i][1] += g0[j] * bf_hi(a[j][i].x) + g1[j] * bf_hi(b[j][i].x);
                    v[j][i][2] += g0[j] * bf_lo(a[j][i].y) + g1[j] * bf_lo(b[j][i].y); v[j][i][3] += g0[j] * bf_hi(a[j][i].y) + g1[j] * bf_hi(b[j][i].y); }
                if (k0[j] | k1[j]) {
#pragma unroll
                    for (int i = 0; i < 4; ++i) {
                        if ((k0[j] >> i) & 1) { const v2u c = *(const v2u*)(Y2 + (size_t)s0[j] * D + 4 * lane + 256 * i); v[j][i][0] += g0[j] * bf_lo(c.x); v[j][i][1] += g0[j] * bf_hi(c.x); v[j][i][2] += g0[j] * bf_lo(c.y); v[j][i][3] += g0[j] * bf_hi(c.y); }
                        if ((k1[j] >> i) & 1) { const v2u c = *(const v2u*)(Y2 + (size_t)s1[j] * D + 4 * lane + 256 * i); v[j][i][0] += g1[j] * bf_lo(c.x); v[j][i][1] += g1[j] * bf_hi(c.x); v[j][i][2] += g1[j] * bf_lo(c.y); v[j][i][3] += g1[j] * bf_hi(c.y); }
                    }
                }
            }
        }
#pragma unroll
        for (int j = 0; j < 2; ++j) { if (j == 1 && !two) break; const int row = row0 + j * NGW;
            if (writeX) {
#pragma unroll
                for (int i = 0; i < 4; ++i) *(f32x4*)(X + (size_t)row * D + 4 * lane + 256 * i) = v[j][i] * oscale;
            }
            if (!XB) continue;
            float sq = 0.f;
#pragma unroll
            for (int i = 0; i < 4; ++i) { sq += v[j][i][0] * v[j][i][0] + v[j][i][1] * v[j][i][1] + v[j][i][2] * v[j][i][2] + v[j][i][3] * v[j][i][3]; v2u o; o.x = pk2(v[j][i][0], v[j][i][1]); o.y = pk2(v[j][i][2], v[j][i][3]); *(v2u*)(XB + (size_t)row * D + 4 * lane + 256 * i) = o; }
            sq = wave_sum(sq);
            if (lane < 16) rstd_out[(size_t)row * 16 + lane] = (lane == 0) ? sq : 0.f;
        }
    }
}
__device__ __forceinline__ void route_phase(const float* __restrict__ X, const float* __restrict__ gain, const float* __restrict__ Wr, int* __restrict__ wgcnt, float* tok_gw,
                                            int gw, int NGW, int lane, LAS float* wr_s, int tid, int& o_row, int& o_e0, int& o_e1, int& o_p0, int& o_p1, float& o_r) {
    for (int idx = tid; idx < 8192; idx += NWAVES * 64) wr_s[(idx & 7) * 1024 + (idx >> 3)] = Wr[idx];
    if (tid < 128) ((LAS int*)(wr_s + 8192))[tid] = 0;
    __syncthreads();
    LAS int* cnt_s = (LAS int*)(wr_s + 8192); LAS int* loc_s = cnt_s + 128 + (tid >> 6) * 64;
    LAS int* wcnt = cnt_s + 8 * (tid >> 6);
    int krow = 0;
    f32x4 gv[4];
#pragma unroll
    for (int i = 0; i < 4; ++i) gv[i] = *(const f32x4*)(gain + 4 * lane + 256 * i);
    for (int row = gw; row < S; row += NGW) {
        f32x4 v[4];
#pragma unroll
        for (int i = 0; i < 4; ++i) v[i] = *(const f32x4*)(X + (size_t)row * D + 4 * lane + 256 * i);
        float sq = 0.f;
#pragma unroll
        for (int i = 0; i < 4; ++i) sq += v[i][0] * v[i][0] + v[i][1] * v[i][1] + v[i][2] * v[i][2] + v[i][3] * v[i][3];
        const float r = rsqrtf(wave_sum(sq) * (1.f / D) + 1e-6f);
#pragma unroll
        for (int i = 0; i < 4; ++i) v[i] = v[i] * r * gv[i];
        float lg[8];
#pragma unroll
        for (int e = 0; e < 8; ++e) lg[e] = 0.f;
#pragma unroll
        for (int e = 0; e < 8; ++e)
#pragma unroll
            for (int i = 0; i < 4; ++i) { const f32x4 w = *(const LAS f32x4*)(wr_s + e * 1024 + 4 * lane + 256 * i); lg[e] += v[i][0] * w[0] + v[i][1] * w[1] + v[i][2] * w[2] + v[i][3] * w[3]; }
#pragma unroll
        for (int e = 0; e < 8; ++e) lg[e] = wave_sum(lg[e]);
        if (lane == 0) {
            int e0 = 0;
#pragma unroll
            for (int e = 1; e < 8; ++e) if (lg[e] > lg[e0]) e0 = e;
            int e1 = (e0 == 0) ? 1 : 0;
#pragma unroll
            for (int e = 0; e < 8; ++e) if (e != e0 && lg[e] > lg[e1]) e1 = e;
            asm volatile("" : "+v"(e0), "+v"(e1));
            const float g1 = 1.f / (1.f + __expf(lg[e0] - lg[e1]));
            tok_gw[2 * row] = 1.f - g1; tok_gw[2 * row + 1] = g1;
            const int r0 = wcnt[e0]; wcnt[e0] = r0 + 1; const int r1 = wcnt[e1]; wcnt[e1] = r1 + 1;
            loc_s[8 * krow] = e0; loc_s[8 * krow + 1] = e1; loc_s[8 * krow + 2] = r0; loc_s[8 * krow + 3] = r1; loc_s[8 * krow + 4] = __float_as_int(r);
        }
        ++krow;
    }
    __syncthreads();
    if (tid < 8) { int run = 0;
#pragma unroll
        for (int w = 0; w < 8; ++w) { cnt_s[64 + 8 * w + tid] = run; run += cnt_s[8 * w + tid]; }
        __hip_atomic_store(wgcnt + blockIdx.x * 8 + tid, run, __ATOMIC_RELAXED, __HIP_MEMORY_SCOPE_AGENT); }
    __syncthreads();
    o_row = -1; o_e0 = 0; o_e1 = 0; o_p0 = 0; o_p1 = 0; o_r = 0.f;
    if (lane < krow) { o_row = gw + lane * NGW; o_e0 = loc_s[8 * lane]; o_e1 = loc_s[8 * lane + 1]; LAS int* pw = cnt_s + 64 + 8 * (tid >> 6);
        o_p0 = pw[o_e0] + loc_s[8 * lane + 2]; o_p1 = pw[o_e1] + loc_s[8 * lane + 3]; o_r = __int_as_float(loc_s[8 * lane + 4]); }
}
__device__ __forceinline__ void perm_phase(int* mctl, const int* __restrict__ wgcnt, int* __restrict__ tok_slot, int* __restrict__ slot_tok, float* __restrict__ slot_rs, LAS int* pre  ,
                                           int gw, int lane, int tid, int row, int e0, int e1, int p0, int p1, float r) {
    __syncthreads();
    if ((int)gridDim.x == 256) {
        const int e = tid >> 6; int c[4];
#pragma unroll
        for (int j = 0; j < 4; ++j) c[j] = wgcnt[(4 * lane + j) * 8 + e];
        const int t4 = (c[0] + c[1]) + (c[2] + c[3]); int incl = t4;
#pragma unroll
        for (int d = 1; d < 64; d <<= 1) { const int o = __shfl_up(incl, d); incl += (lane >= d) ? o : 0; }
        const int ex = incl - t4;
        pre[(4 * lane) * 8 + e] = ex; pre[(4 * lane + 1) * 8 + e] = ex + c[0]; pre[(4 * lane + 2) * 8 + e] = ex + c[0] + c[1]; pre[(4 * lane + 3) * 8 + e] = ex + c[0] + c[1] + c[2];
        if (lane == 63) pre[2048 + e] = incl;
    } else if (tid < 8) { int run = 0; for (int b = 0; b < (int)gridDim.x; ++b) { pre[b * 8 + tid] = run; run += wgcnt[b * 8 + tid]; } pre[2048 + tid] = run; }
    __syncthreads();
    int base[8]; int off = 0;
#pragma unroll
    for (int e = 0; e < 8; ++e) { base[e] = off; off += ((pre[2048 + e] + 255) >> 8) << 8; }
    if (gw == 0) {
        const int nt = off >> 8;
        for (int i = lane; i < nt; i += 64) { int e = 0;
#pragma unroll
            for (int k = 1; k < 8; ++k) e = (i >= (base[k] >> 8)) ? k : e;
            mctl[32 + i] = e; }
        if (lane == 0) mctl[16] = nt;
        const int units = nt * (D / 256);
        if ((int)gridDim.x == 256 && units > 512) { pg8::StaticOrder so; so.init(nt * 256, D, 256, 0, WGM_DNM);
            for (int L = 512 + lane; L < units; L += 64) { pg8::Unit u; so.unit_of(L, u); atomicOr(mctl + 256 + u.pm, 1 << u.pn); } }
    }
    if (row >= 0) {
        int b0 = base[0], b1 = base[0];
#pragma unroll
        for (int k = 1; k < 8; ++k) { b0 = (e0 == k) ? base[k] : b0; b1 = (e1 == k) ? base[k] : b1; }
        const int s0 = b0 + pre[blockIdx.x * 8 + e0] + p0, s1 = b1 + pre[blockIdx.x * 8 + e1] + p1;
        tok_slot[2 * row] = s0; tok_slot[2 * row + 1] = s1; slot_tok[s0] = row; slot_tok[s1] = row; slot_rs[s0] = r; slot_rs[s1] = r;
    }
    if (gw < 8) { const int e = gw; int b = base[0], nb = off;
#pragma unroll
        for (int k = 1; k < 8; ++k) { b = (e == k) ? base[k] : b; }
#pragma unroll
        for (int k = 1; k < 8; ++k) { nb = (e == k - 1) ? base[k] : nb; }
        for (int s = b + pre[2048 + e] + lane; s < nb; s += 64) slot_tok[s] = 0; }
    __syncthreads();
}

struct SsmPar { const float *lam_re, *lam_im, *log_dt, *b_re, *b_im, *c_re, *c_im, *d_skip; };
__device__ __forceinline__ void ssm_coef(const SsmPar& sp, int g, int p, float& are, float& aim, float (&bbr)[16], float (&bbi)[16]) {
    const float dt = expf(sp.log_dt[g]); const float lre = sp.lam_re[g * 64 + p], lim = sp.lam_im[g * 64 + p];
    const float mag = expf(lre * dt), ang = lim * dt; are = mag * cosf(ang); aim = mag * sinf(ang);
    const float nre = are - 1.f, nim = aim, den = lre * lre + lim * lim;
    const float zre = (nre * lre + nim * lim) / den, zim = (nim * lre - nre * lim) / den;
#pragma unroll
    for (int c = 0; c < 16; ++c) { const float br = sp.b_re[(g * 64 + p) * 16 + c], bi = sp.b_im[(g * 64 + p) * 16 + c]; bbr[c] = zre * br - zim * bi; bbi[c] = zre * bi + zim * br; }
}
typedef short sbf16x8 __attribute__((ext_vector_type(8)));

__device__ __forceinline__ void ssm_table_task(const SsmPar& sp, float2* __restrict__ atab, bf16* __restrict__ btab, int lg  , int g, int lane) {
    float are, aim, bbr[16], bbi[16]; ssm_coef(sp, g, lane, are, aim, bbr, bbi);
    atab[(size_t)lg * 64 + lane] = make_float2(are, aim);
    v4u w0, w1, w2, w3;
    w0.x = pk2(bbr[0], bbr[1]); w0.y = pk2(bbr[2], bbr[3]); w0.z = pk2(bbr[4], bbr[5]); w0.w = pk2(bbr[6], bbr[7]);
    w1.x = pk2(bbr[8], bbr[9]); w1.y = pk2(bbr[10], bbr[11]); w1.z = pk2(bbr[12], bbr[13]); w1.w = pk2(bbr[14], bbr[15]);
    w2.x = pk2(bbi[0], bbi[1]); w2.y = pk2(bbi[2], bbi[3]); w2.z = pk2(bbi[4], bbi[5]); w2.w = pk2(bbi[6], bbi[7]);
    w3.x = pk2(bbi[8], bbi[9]); w3.y = pk2(bbi[10], bbi[11]); w3.z = pk2(bbi[12], bbi[13]); w3.w = pk2(bbi[14], bbi[15]);
    v4u* d = (v4u*)(btab + ((size_t)lg * 128 + 2 * lane) * 16);
    d[0] = w0; d[1] = w1; d[2] = w2; d[3] = w3;
}
typedef float f32x16s __attribute__((ext_vector_type(16)));
typedef float f32x2v __attribute__((ext_vector_type(2)));
constexpr int BU_PITCH = 528;
__device__ __forceinline__ void ssm_bu_mfma(f32x16s (&D)[4], const sbf16x8 (&af)[4], const bf16* __restrict__ P, int tok0, int g, int lane) {
    const int r = lane & 31, h = lane >> 5;
    const sbf16x8 bfr = *(const sbf16x8*)(P + (size_t)(tok0 + r) * PPITCH + O_U + g * 16 + 8 * h);
#pragma unroll
    for (int mt = 0; mt < 4; ++mt) { f32x16s z;
#pragma unroll
        for (int i = 0; i < 16; ++i) z[i] = 0.f;
        D[mt] = __builtin_amdgcn_mfma_f32_32x32x16_bf16(af[mt], bfr, z, 0, 0, 0); }
}
__device__ __forceinline__ void ssm_bu_store(const f32x16s (&D)[4], LAS unsigned char* bu, int sub, int lane) {
    const int r = lane & 31, h = lane >> 5;
    if ((r >> 4) == sub) {
#pragma unroll
        for (int mt = 0; mt < 4; ++mt)
#pragma unroll
            for (int g4 = 0; g4 < 4; ++g4) *(LAS f32x4*)(bu + (r & 15) * BU_PITCH + (32 * mt + 8 * g4 + 4 * h) * 4) = (f32x4){D[mt][4 * g4], D[mt][4 * g4 + 1], D[mt][4 * g4 + 2], D[mt][4 * g4 + 3]};
    }
}
__device__ __forceinline__ void ssm_load_af(sbf16x8 (&af)[4], const bf16* __restrict__ btab, int lg, int lane) {
    const int r = lane & 31, h = lane >> 5;
#pragma unroll
    for (int mt = 0; mt < 4; ++mt) af[mt] = *(const sbf16x8*)(btab + ((size_t)lg * 128 + 32 * mt + r) * 16 + 8 * h);
}
__device__ __forceinline__ void ssm_a2_task(const bf16* __restrict__ P, const float2* __restrict__ atab, const bf16* __restrict__ btab, float2* __restrict__ Send, LAS unsigned char* wl, int lg, int g, int cp, int lane) {
    const float2 a = atab[(size_t)lg * 64 + lane]; const float are = a.x, aim = a.y;
    sbf16x8 af[4]; ssm_load_af(af, btab, lg, lane);
    float xr = 0.f, xi = 0.f;
    for (int nt = 0; nt < 4; ++nt) {
        f32x16s Dt[4]; ssm_bu_mfma(Dt, af, P, cp * 128 + 32 * nt, g, lane);
#pragma unroll
        for (int sub = 0; sub < 2; ++sub) {
            LDS_WAIT();
            ssm_bu_store(Dt, wl, sub, lane);
            LDS_WAIT();
#pragma unroll 4
            for (int s = 0; s < 16; ++s) { const f32x2v b = *(const LAS f32x2v*)(wl + s * BU_PITCH + lane * 8); const float nr = are * xr - aim * xi + b.x, ni = are * xi + aim * xr + b.y; xr = nr; xi = ni; }
        }
    }
    __hip_atomic_store((unsigned long long*)(Send + ((size_t)g * 128 + cp) * 64 + lane), ((unsigned long long)__float_as_uint(xi) << 32) | (unsigned long long)__float_as_uint(xr), __ATOMIC_RELAXED, __HIP_MEMORY_SCOPE_AGENT);
}
__device__ __forceinline__ void ssm_c2_task(const bf16* __restrict__ P, const SsmPar& sp, const float2* __restrict__ atab, const bf16* __restrict__ btab, const float2* __restrict__ Send, bf16* __restrict__ YG,
                                            LAS unsigned char* wl, int lg, int g, int cp, int lane) {
    const float2 a = atab[(size_t)lg * 64 + lane]; const float are = a.x, aim = a.y;
    sbf16x8 af[4]; ssm_load_af(af, btab, lg, lane);
    LAS unsigned char* bu = wl;
    LAS unsigned char* xs = wl + 8448;
    const int fr = lane & 15, fq = lane >> 4;
    sbf16x8 cf[4];
#pragma unroll
    for (int kk = 0; kk < 4; ++kk) {
        const f32x4 cr = *(const f32x4*)(sp.c_re + (size_t)(g * 16 + fr) * 64 + 16 * kk + 4 * fq), ci = *(const f32x4*)(sp.c_im + (size_t)(g * 16 + fr) * 64 + 16 * kk + 4 * fq);
        v4u w; w.x = pk2(cr[0], -ci[0]); w.y = pk2(cr[1], -ci[1]); w.z = pk2(cr[2], -ci[2]); w.w = pk2(cr[3], -ci[3]);
        cf[kk] = __builtin_bit_cast(sbf16x8, w);
    }
    const f32x4 dsk = *(const f32x4*)(sp.d_skip + g * 16 + 4 * fq);
    float pr = are, pi = aim;
#pragma unroll
    for (int i = 0; i < 7; ++i) { const float nr = pr * pr - pi * pi, ni = 2.f * pr * pi; pr = nr; pi = ni; }
    float xr = 0.f, xi = 0.f;
    {
        const float2* sp0 = Send + (size_t)g * 128 * 64 + lane; const int nc = cp; int c = 0;
        for (; c + 64 <= nc; c += 64) { float2 s[64];
#pragma unroll
            for (int j = 0; j < 64; ++j) s[j] = sp0[(size_t)(c + j) * 64];
#pragma unroll
            for (int j = 0; j < 64; ++j) { const float nr = pr * xr - pi * xi + s[j].x, ni = pr * xi + pi * xr + s[j].y; xr = nr; xi = ni; } }
        for (; c + 32 <= nc; c += 32) { float2 s[32];
#pragma unroll
            for (int j = 0; j < 32; ++j) s[j] = sp0[(size_t)(c + j) * 64];
#pragma unroll
            for (int j = 0; j < 32; ++j) { const float nr = pr * xr - pi * xi + s[j].x, ni = pr * xi + pi * xr + s[j].y; xr = nr; xi = ni; } }
        for (; c + 8 <= nc; c += 8) { float2 s[8];
#pragma unroll
            for (int j = 0; j < 8; ++j) s[j] = sp0[(size_t)(c + j) * 64];
#pragma unroll
            for (int j = 0; j < 8; ++j) { const float nr = pr * xr - pi * xi + s[j].x, ni = pr * xi + pi * xr + s[j].y; xr = nr; xi = ni; } }
        for (; c < nc; ++c) { const float2 s = sp0[(size_t)c * 64]; const float nr = pr * xr - pi * xi + s.x, ni = pr * xi + pi * xr + s.y; xr = nr; xi = ni; }
    }
    for (int q = 0; q < 4; ++q) {
        const int tok0 = cp * 128 + 32 * q;
        f32x16s Dt[4]; ssm_bu_mfma(Dt, af, P, tok0, g, lane);
#pragma unroll
        for (int sub = 0; sub < 2; ++sub) {
            LDS_WAIT();
            ssm_bu_store(Dt, bu, sub, lane);
            LDS_WAIT();
#pragma unroll 4
            for (int s = 0; s < 16; ++s) { const f32x2v b = *(const LAS f32x2v*)(bu + s * BU_PITCH + lane * 8); const float nr = are * xr - aim * xi + b.x, ni = are * xi + aim * xr + b.y; xr = nr; xi = ni;
                *(LAS unsigned*)(xs + s * 272 + lane * 4) = pk2(xr, xi); }
            LDS_WAIT();
            f32x4 acc = (f32x4){0.f, 0.f, 0.f, 0.f};
#pragma unroll
            for (int kk = 0; kk < 4; ++kk) { const sbf16x8 xf = *(const LAS sbf16x8*)(xs + fr * 272 + 64 * kk + 16 * fq); acc = __builtin_amdgcn_mfma_f32_16x16x32_bf16(cf[kk], xf, acc, 0, 0, 0); }
            const int tok = tok0 + 16 * sub + fr;
            const v2u ub = *(const v2u*)(P + (size_t)tok * PPITCH + O_U + g * 16 + 4 * fq);
            const float u0 = bf_lo(ub.x), u1 = bf_hi(ub.x), u2 = bf_lo(ub.y), u3 = bf_hi(ub.y);
            float o[4]; const float uu[4] = {u0, u1, u2, u3};
#pragma unroll
            for (int e = 0; e < 4; ++e) { const float y = acc[e] + dsk[e] * uu[e]; const float u2 = 1.5957691216057308f * (y + 0.044715f * y * y * y); o[e] = y * __builtin_amdgcn_rcpf(1.f + __expf(-u2)); }
            v2u w; w.x = pk2(o[0], o[1]); w.y = pk2(o[2], o[3]);
            __hip_atomic_store((unsigned long long*)(YG + (size_t)tok * 256 + g * 16 + 4 * fq), ((unsigned long long)w.y << 32) | (unsigned long long)w.x, __ATOMIC_RELAXED, __HIP_MEMORY_SCOPE_AGENT);
        }
    }
}


typedef short bf16x8 __attribute__((ext_vector_type(8)));
typedef short s16x4 __attribute__((ext_vector_type(4)));
typedef short v4i16_t __attribute__((ext_vector_type(4)));
typedef float f32x16 __attribute__((ext_vector_type(16)));
typedef float f32x2_t __attribute__((ext_vector_type(2))); typedef __bf16 bf16x2_t __attribute__((ext_vector_type(2)));
#define MFMA32(a, b, c) __builtin_amdgcn_mfma_f32_32x32x16_bf16((a), (b), (c), 0, 0, 0)
__device__ __forceinline__ unsigned cvtpk_s(float lo, float hi) { f32x2_t v = {lo, hi}; bf16x2_t b = __builtin_convertvector(v, bf16x2_t); return __builtin_bit_cast(unsigned, b); }
__device__ __forceinline__ s16x4 vtr(const LAS unsigned char* p) { return __builtin_bit_cast(s16x4, __builtin_amdgcn_ds_read_tr16_b64_v4i16((LAS v4i16_t*)p)); }
__device__ __forceinline__ bf16x8 pack_step(const f32x16& x, int s) {
    v4u p; p.x = cvtpk_s(x[8 * s], x[8 * s + 1]); p.y = cvtpk_s(x[8 * s + 2], x[8 * s + 3]); p.z = cvtpk_s(x[8 * s + 4], x[8 * s + 5]); p.w = cvtpk_s(x[8 * s + 6], x[8 * s + 7]);
    return __builtin_bit_cast(bf16x8, p);
}
__device__ __forceinline__ void load_kfrags(bf16x8 (&kf)[2][4], const bf16* __restrict__ kbase  , int r, int h) {
#pragma unroll
    for (int kb = 0; kb < 2; ++kb)
#pragma unroll
        for (int st = 0; st < 4; ++st) kf[kb][st] = *(const bf16x8*)(kbase + (size_t)(32 * kb + r) * PPITCH + 16 * st + 8 * h);
}
__device__ __forceinline__ void load_vregs(v4u (&vr)[8], const bf16* __restrict__ vbase, int lane) {
#pragma unroll
    for (int i = 0; i < 8; ++i) vr[i] = *(const v4u*)(vbase + (size_t)(i * 8 + (lane >> 3)) * PPITCH + (lane & 7) * 8);
}
__device__ __forceinline__ void store_vtile(const v4u (&vr)[8], LAS unsigned char* vt, int lane) {
    const int c = lane & 7;
#pragma unroll
    for (int i = 0; i < 8; ++i) *(LAS v4u*)(vt + (c >> 2) * 4096 + (i * 8 + (lane >> 3)) * 64 + (c & 3) * 16) = vr[i];
}
__device__ __forceinline__ void qk_tile(f32x16 (&x)[2], const bf16x8 (&kf)[2][4], const bf16x8 (&qf)[4]) {
#pragma unroll
    for (int kb = 0; kb < 2; ++kb) {
        f32x16 a;
#pragma unroll
        for (int i = 0; i < 16; ++i) a[i] = 0.f;
#pragma unroll
        for (int st = 0; st < 4; ++st) a = MFMA32(kf[kb][st], qf[st], a);
        x[kb] = a;
    }
}
__device__ __forceinline__ void pv_tile(f32x16 (&oT)[2], const f32x16 (&p)[2], const LAS unsigned char* vt, int lane) {
    const int i16 = lane & 15, q = i16 >> 2, pp = i16 & 3, blk = (lane >> 4) & 1, h = lane >> 5;
    const LAS unsigned char* vb = vt + (4 * h + q) * 64 + 8 * (4 * blk + pp);
#pragma unroll
    for (int kb = 0; kb < 2; ++kb)
#pragma unroll
        for (int s = 0; s < 2; ++s) {
            const bf16x8 xs = pack_step(p[kb], s);
#pragma unroll
            for (int dt = 0; dt < 2; ++dt) {
                const s16x4 lo = vtr(vb + dt * 4096 + (32 * kb + 16 * s) * 64), hi = vtr(vb + dt * 4096 + (32 * kb + 16 * s + 8) * 64);
                const bf16x8 pa = __builtin_shufflevector(lo, hi, 0, 1, 2, 3, 4, 5, 6, 7);
                oT[dt] = MFMA32(pa, xs, oT[dt]);
            }
        }
}
__device__ __forceinline__ void store_oT(const f32x16 (&oT)[2], float sc, bf16* __restrict__ orow  , int h, float* __restrict__ ssq_row  ) {
    float sq = 0.f;
#pragma unroll
    for (int dt = 0; dt < 2; ++dt)
#pragma unroll
        for (int g = 0; g < 4; ++g) { const float a = oT[dt][4 * g] * sc, b = oT[dt][4 * g + 1] * sc, c = oT[dt][4 * g + 2] * sc, d = oT[dt][4 * g + 3] * sc; sq += a * a + b * b + c * c + d * d;
            v2u w; w.x = cvtpk_s(a, b); w.y = cvtpk_s(c, d);
            *(v2u*)(orow + 32 * dt + 8 * g + 4 * h) = w; }
    sq += __shfl_xor(sq, 32);
    if (h == 0) *ssq_row = sq;
}

__device__ __forceinline__ void sb_task_mfma(const bf16* __restrict__ P, bf16* __restrict__ MIXRAW, float* __restrict__ ssq, LAS unsigned char* wl, int head, int q0, int lane) {
    const int r = lane & 31, h = lane >> 5;
    bf16x8 qf[4];
#pragma unroll
    for (int st = 0; st < 4; ++st) qf[st] = *(const bf16x8*)(P + (size_t)(q0 + r) * PPITCH + O_QSB + head * 64 + 16 * st + 8 * h);
    f32x16 oT[2];
#pragma unroll
    for (int i = 0; i < 16; ++i) { oT[0][i] = 0.f; oT[1][i] = 0.f; }
    float carry = 0.f;
    const int kt0 = q0 >> 6;
    for (int kt = kt0; kt >= 0; --kt) {
        bf16x8 kf[2][4]; v4u vr[8];
        load_kfrags(kf, P + (size_t)kt * 64 * PPITCH + O_KSB + head * 64, r, h);
        load_vregs(vr, P + (size_t)kt * 64 * PPITCH + O_VSB + head * 64, lane);
        f32x16 x[2];
        qk_tile(x, kf, qf);
        LDS_WAIT();
        store_vtile(vr, wl, lane);
        const bool diag = (kt == kt0);
        f32x16 ln[2];
#pragma unroll
        for (int kb = 0; kb < 2; ++kb)
#pragma unroll
            for (int i = 0; i < 16; ++i) {
                const float z = x[kb][i];
                float l = -(fmaxf(z, 0.f) + flog2(1.f + fexp2(-fabsf(z))));
                if (diag) { const int kpos = kt * 64 + 32 * kb + (i & 3) + 8 * (i >> 2) + 4 * h; l = (kpos < q0 + r) ? l : 0.f; }
                ln[kb][i] = l;
            }
        float Tm[8], Tp[8], suf[2][16];
#pragma unroll
        for (int kb = 0; kb < 2; ++kb)
#pragma unroll
            for (int g = 0; g < 4; ++g) {
                const float e0 = ln[kb][4 * g], e1 = ln[kb][4 * g + 1], e2 = ln[kb][4 * g + 2], e3 = ln[kb][4 * g + 3];
                suf[kb][4 * g + 3] = 0.f; suf[kb][4 * g + 2] = e3; suf[kb][4 * g + 1] = e3 + e2; suf[kb][4 * g] = e3 + e2 + e1;
                Tm[4 * kb + g] = (e3 + e2) + (e1 + e0);
            }
#pragma unroll
        for (int i = 0; i < 8; ++i) Tp[i] = __shfl_xor(Tm[i], 32);
        float R[8]; R[7] = 0.f;
#pragma unroll
        for (int i = 6; i >= 0; --i) R[i] = R[i + 1] + (Tm[i + 1] + Tp[i + 1]);
        const float tile_total = R[0] + (Tm[0] + Tp[0]);
        f32x16 w[2];
#pragma unroll
        for (int kb = 0; kb < 2; ++kb)
#pragma unroll
            for (int g = 0; g < 4; ++g) {
                const int gi = 4 * kb + g;
                const float off = carry + R[gi] + (h ? 0.f : Tp[gi]);
#pragma unroll
                for (int e = 0; e < 4; ++e) {
                    const int i = 4 * g + e;
                    float ww = fexp2(x[kb][i] + ln[kb][i] + (off + suf[kb][i]));
                    if (diag) { const int kpos = kt * 64 + 32 * kb + e + 8 * g + 4 * h; ww = (kpos < q0 + r) ? ww : 0.f; }
                    w[kb][i] = ww;
                }
            }
        carry += tile_total;
        pv_tile(oT, w, wl, lane);
        if (__all(carry < SB_STOP)) break;
    }
    store_oT(oT, 1.f, MIXRAW + (size_t)(q0 + r) * D + 256 + head * 64, h, ssq + (size_t)(q0 + r) * 4 + head);
}

__device__ __forceinline__ void ca_unit(const bf16* __restrict__ P, const float* __restrict__ rel_bias, bf16* __restrict__ MIXRAW, float* __restrict__ ssq, LAS unsigned char* sh, int head, int c0, int wave, int lane, int tid) {
    const int r = lane & 31, h = lane >> 5, ci = c0 + (wave >> 1), q0 = 64 * ci + 32 * (wave & 1);
    LAS unsigned char* Ks = sh; LAS unsigned char* Vs = sh + 16384; LAS float* bias_s = (LAS float*)(sh + 32768);
    __syncthreads();
    for (int i = tid; i < 320; i += NWAVES * 64) bias_s[i] = rel_bias[head * 257 + (i < 256 ? i : 256)] * LOG2E;
    bf16x8 qf[4];
#pragma unroll
    for (int st = 0; st < 4; ++st) qf[st] = *(const bf16x8*)(P + (size_t)(q0 + r) * PPITCH + O_QCA + head * 64 + 16 * st + 8 * h);
    f32x16 oT[2];
#pragma unroll
    for (int i = 0; i < 16; ++i) { oT[0][i] = 0.f; oT[1][i] = 0.f; }
    float m = -1e30f, l = 0.f;
    const int t0 = (c0 >= 8 ? c0 - 8 : 0), t1 = c0 + 3;
    const int srow = tid >> 3, sc = tid & 7;
    const int koff = srow * 128 + ((sc ^ (srow & 7)) << 4), voff = (sc >> 2) * 4096 + srow * 64 + (sc & 3) * 16;
    v4u kreg = *(const v4u*)(P + (size_t)(t0 * 64 + srow) * PPITCH + O_KCA + head * 64 + sc * 8);
    v4u vreg = *(const v4u*)(P + (size_t)(t0 * 64 + srow) * PPITCH + O_VCA + head * 64 + sc * 8);
    *(LAS v4u*)(Ks + koff) = kreg; *(LAS v4u*)(Vs + voff) = vreg;
    __syncthreads();
    const float bfar = bias_s[256];
    for (int t = t0; t <= t1; ++t) {
        const int cur = (t - t0) & 1;
        if (t < t1) { kreg = *(const v4u*)(P + (size_t)((t + 1) * 64 + srow) * PPITCH + O_KCA + head * 64 + sc * 8); vreg = *(const v4u*)(P + (size_t)((t + 1) * 64 + srow) * PPITCH + O_VCA + head * 64 + sc * 8); }
        if (t <= ci && t + 8 >= ci) {
            const LAS unsigned char* kb_ = Ks + cur * 8192;
            bf16x8 kf[2][4];
#pragma unroll
            for (int kb = 0; kb < 2; ++kb)
#pragma unroll
                for (int st = 0; st < 4; ++st) { const int row = 32 * kb + r; kf[kb][st] = *(const LAS bf16x8*)(kb_ + row * 128 + (((2 * st + h) ^ (row & 7)) << 4)); }
            f32x16 x[2];
            qk_tile(x, kf, qf);
            float badd = bfar;
            if (ci - t < 3) { badd = 0.f;
                const LAS float* bp = bias_s + ((q0 + r) - t * 64 - 4 * h + 128);
#pragma unroll
                for (int kb = 0; kb < 2; ++kb)
#pragma unroll
                    for (int i = 0; i < 16; ++i) x[kb][i] += bp[-(32 * kb + (i & 3) + 8 * (i >> 2))];
            }
            float tm = x[0][0];
#pragma unroll
            for (int kb = 0; kb < 2; ++kb)
#pragma unroll
                for (int i = 0; i < 16; ++i) tm = fmaxf(tm, x[kb][i]);
            tm = fmaxf(tm, __shfl_xor(tm, 32)) + badd;
            if (__any(tm > m)) {
                const float mn = fmaxf(m, tm), scl = fexp2(m - mn); m = mn; l *= scl;
#pragma unroll
                for (int i = 0; i < 16; ++i) { oT[0][i] *= scl; oT[1][i] *= scl; }
            }
            const float mm = m - badd; const f32x2v mm2 = {mm, mm}; f32x2v ps2 = {0.f, 0.f};
#pragma unroll
            for (int kb = 0; kb < 2; ++kb)
#pragma unroll
                for (int i = 0; i < 16; i += 2) { f32x2v v = {x[kb][i], x[kb][i + 1]}; v = v - mm2; f32x2v p; p.x = fexp2(v.x); p.y = fexp2(v.y); x[kb][i] = p.x; x[kb][i + 1] = p.y; ps2 = ps2 + p; }
            l += ps2.x + ps2.y;
            pv_tile(oT, x, Vs + cur * 8192, lane);
        }
        if (t < t1) { *(LAS v4u*)(Ks + (cur ^ 1) * 8192 + koff) = kreg; *(LAS v4u*)(Vs + (cur ^ 1) * 8192 + voff) = vreg; }
        __syncthreads();
    }
    l += __shfl_xor(l, 32);
    store_oT(oT, 1.f / l, MIXRAW + (size_t)(q0 + r) * D + 512 + head * 64, h, ssq + (size_t)(q0 + r) * 8 + head);
}
#define XB_TMO      128
#define XB_XCNT(j)  (256  + 64 * (j))
#define XB_XSUB(j)  (1280 + 64 * (j))
#define XB_XGEN(j)  (2304 + 64 * (j))
#define XB_TOP      3328
#define XB_TOPGEN   3392
#define XCD_BAR_WORDS 3456
#define XB_SPIN_CAP (1u << 18)

__device__ __forceinline__ unsigned xb_ld(unsigned* p)              { return __hip_atomic_load(p, __ATOMIC_RELAXED, __HIP_MEMORY_SCOPE_AGENT); }
__device__ __forceinline__ unsigned xb_add(unsigned* p, unsigned v) { return __hip_atomic_fetch_add(p, v, __ATOMIC_RELAXED, __HIP_MEMORY_SCOPE_AGENT); }
__device__ __forceinline__ unsigned xb_xcc_id() { return (unsigned)__builtin_amdgcn_s_getreg((3 << 11) | 20) & 0xFu; }
#define XB_SPIN(cond, bar) do { unsigned _sp = 0; while (cond) { __builtin_amdgcn_s_sleep(1); \
    if ((++_sp & 255u) == 0u) { if (xb_ld(&(bar)[XB_TMO])) break; if (_sp > XB_SPIN_CAP) { atomicAdd(&(bar)[XB_TMO], 1u); break; } } } } while (0)

struct XcdBarrier {
    int wv;
    unsigned* bar; unsigned x;
    volatile LAS unsigned* st;
};

__device__ __forceinline__ XcdBarrier xcd_barrier_post(unsigned* bar, volatile LAS unsigned* st) {
    XcdBarrier b; b.bar = bar; b.x = xb_xcc_id(); b.st = st;
    if (threadIdx.x == 0) (void)xb_add(&bar[XB_XCNT(b.x)], 1u);
    return b;
}
__device__ __forceinline__ void xcd_barrier_complete(unsigned* bar, unsigned x, unsigned& nloc, unsigned& nx) {
    const unsigned G = gridDim.x * gridDim.y * gridDim.z;
    unsigned sum, cnt, mine, sp = 0u;
    for (;;) {
        sum = 0u; cnt = 0u; mine = 0u;
#pragma unroll
        for (unsigned j = 0; j < 16; ++j) { const unsigned c = xb_ld(&bar[XB_XCNT(j)]); sum += c; cnt += (c > 0u) ? 1u : 0u; mine = (j == x) ? c : mine; }
        if (sum == G) break;
        __builtin_amdgcn_s_sleep(1);
        if ((++sp & 255u) == 0u) { if (xb_ld(&bar[XB_TMO])) break; if (sp > XB_SPIN_CAP) { atomicAdd(&bar[XB_TMO], 1u); break; } }
    }
    nloc = mine > 0u ? mine : 1u; nx = cnt > 0u ? cnt : 1u;
}

__device__ __forceinline__ void xcd_barrier(const XcdBarrier& b) {
    asm volatile("s_waitcnt vmcnt(0)" ::: "memory");
    __syncthreads();
    if (b.wv == 0 && __builtin_amdgcn_mbcnt_hi(~0u, __builtin_amdgcn_mbcnt_lo(~0u, 0u)) == 0u) {
        unsigned* bar = b.bar;
        __builtin_amdgcn_s_waitcnt(0);
        unsigned nloc = b.st[0], nx = b.st[1];
        if (nloc == 0u) { xcd_barrier_complete(bar, b.x, nloc, nx); b.st[0] = nloc; b.st[1] = nx; }
        const unsigned old = xb_add(&bar[XB_XSUB(b.x)], 1u);
        const unsigned gen = old / nloc;
        if (old + 1u == (gen + 1u) * nloc) {
            __builtin_amdgcn_fence(__ATOMIC_RELEASE, "agent");
            asm volatile("s_waitcnt vmcnt(0)" ::: "memory");
            const unsigned og = xb_add(&bar[XB_TOP], 1u);
            const unsigned tg = og / nx;
            if (og + 1u == (tg + 1u) * nx) xb_add(&bar[XB_TOPGEN], 1u);
            else XB_SPIN(xb_ld(&bar[XB_TOPGEN]) == tg, bar);
            __builtin_amdgcn_fence(__ATOMIC_ACQUIRE, "agent");
            xb_add(&bar[XB_XGEN(b.x)], 1u);
            asm volatile("s_waitcnt vmcnt(0)" ::: "memory");
        } else {
            XB_SPIN(xb_ld(&bar[XB_XGEN(b.x)]) == gen, bar);
            __builtin_amdgcn_fence(__ATOMIC_ACQUIRE, "agent");
            asm volatile("s_waitcnt vmcnt(0)" ::: "memory");
        }
    }
    __syncthreads();
}

typedef const Args __attribute__((address_space(4)))* CArgs;
#define LARGS() ({ CArgs p_ = (CArgs)__builtin_amdgcn_kernarg_segment_ptr(); asm volatile("" : "+s"(p_)); p_; })
#define LINT(x) ({ int v_ = (x); asm volatile("" : "+s"(v_)); v_; })

#define PH_BEGIN(kind)
#define PH_END(kind)
#define SEAM() do { if (ONE_LAUNCH) { XcdBarrier b_ = bar; asm volatile("" : "+s"(b_.bar)); xcd_barrier(b_); } } while (0)
#define IN(k) ({ CArgs a_ = LARGS(); const int k_ = (k); a_->ph_lo <= k_ && k_ < a_->ph_hi; })
#define PTID() ({ int t_; asm volatile("v_mbcnt_lo_u32_b32 %0, -1, 0\n\tv_mbcnt_hi_u32_b32 %0, -1, %0" : "=v"(t_)); wave_s * 64 + t_; })
#define FILL_SHORT(units, budget) do { const int u_ = (units) % (int)gridDim.x; if (u_ != 0) { WAVE_IDS(); conv_fill(LARGS(), cvc, u_, (budget), (LAS float*)wl, wave, lane); } } while (0)
#define DRAIN(req) do { conv_drain(LARGS(), cvc, (req), (LAS float*)wl, wave, lane); } while (0)
#define RS_PREPASS(So, ss16) do { const int tid_ = PTID(); LAS float* rt_ = (LAS float*)(lds + RS_OFF); \
    for (int i_ = 0; i_ < 12; ++i_) { const long L_ = (long)i_ * (So).G + (So).c; if (L_ >= (So).nwg) break; pg8::Unit u_; (So).unit_of((int)L_, u_); \
        if (tid_ < 256) { const float* p_ = (ss16) + ((size_t)u_.pm * 256 + tid_) * 16; rt_[i_ * 256 + tid_] = rsqrtf(pg8::sum16f(p_) * (1.f / D) + 1e-6f); } } \
    __syncthreads(); } while (0)
#define WAVE_IDS() const int tid = PTID(), lane = tid & 63, wave = wave_s; const int G = gridDim.x, bx = blockIdx.x; const int gw = bx * NWAVES + wave, NGW = G * NWAVES; LAS unsigned char* wl = lds + wave * WAVE_LDS; (void)wl; (void)gw; (void)NGW; (void)lane; (void)G; (void)bx

template <int lraw> __device__ __forceinline__ void layer_body(LAS unsigned char* lds, const XcdBarrier& bar, const int wave_s, int& cvc) {
    constexpr bool MOE = (lraw & 1) != 0;
    constexpr int CVB_NEXT = lraw == 0 ? CV_B1 : (lraw == 1 ? CV_B2 : (lraw == 2 ? CV_B3 : CV_M3));
    if (!MOE) if (IN(1 + lraw * PH_PER_LAYER + 0)) { PH_BEGIN(1);
        WAVE_IDS(); CArgs A = LARGS(); unsigned char* ws = A->ws;
        row_phase(lraw == 0 ? A->in[0] : A->out, A->out, lraw != 0, lraw == 0 ? nullptr : (const bf16*)(ws + WS_R2), (const bf16*)(ws + WS_Y2), (const int*)(ws + WS_CTL) + CW_MOE + 0 * MOE_WORDS + 256, (const int*)(ws + WS_TOKSLOT), (const float*)(ws + WS_TOKG), (bf16*)(ws + WS_H), (float*)(ws + SS_A), gw, NGW, lane);
        DRAIN(lraw == 0 ? CV_B0 : CV_B2);
        SEAM(); PH_END(1);
    }
    if (IN(1 + lraw * PH_PER_LAYER + 1)) { PH_BEGIN(2);
        CArgs A = LARGS(); const int l = LINT(lraw); unsigned char* ws = A->ws;
        pg8::Gemm g{(const bf16*)(ws + WS_H), (const bf16*)(ws + WS_WIN + l * WIN_BYTES), S, DPROJ, D, nullptr, 0, PTID()}; pg8::StaticOrder So; So.init(S, DPROJ, gridDim.x, blockIdx.x, WGM_INPROJ);
        pg8::EpiInProj E{(bf16*)(ws + WS_PROJ), A->in[3] + l * 64, A->in[4] + l * 64, A->in[5] + l * 64, A->in[6] + l * 64, QSCALE, (const LAS float*)(lds + RS_OFF), PPITCH};
        RS_PREPASS(So, (const float*)(ws + SS_A));
        pg8::gemm_phase<pg8::EpiInProj, pg8::StaticOrder, true, true>(lds, g, So, E);
        FILL_SHORT((S / 256) * (DPROJ / 256), FILL_B1);
        SEAM(); PH_END(2);
    }
    if (IN(1 + lraw * PH_PER_LAYER + 2)) { PH_BEGIN(3);
        WAVE_IDS(); CArgs A = LARGS(); const int l = LINT(lraw); unsigned char* ws = A->ws;
        const bf16* PROJ = (const bf16*)(ws + WS_PROJ); bf16* MIXRAW = (bf16*)(ws + WS_MIXRAW);
        SsmPar sp{A->in[8] + l * 1024, A->in[9] + l * 1024, A->in[10] + l * 16, A->in[11] + (size_t)l * 16384, A->in[12] + (size_t)l * 16384, A->in[13] + (size_t)l * 16384, A->in[14] + (size_t)l * 16384, A->in[15] + l * 256};
        unsigned* flag = (unsigned*)(ws + WS_CTL) + CW_SSMF + 64 * l;
        for (int t = gw; t < 2048; t += NGW) ssm_a2_task(PROJ, (const float2*)(ws + TAB_A), (const bf16*)(ws + TAB_B), (float2*)(ws + WS_SEND), wl, l * 16 + (t & 15), t & 15, t >> 4, lane);
        asm volatile("s_waitcnt vmcnt(0)" ::: "memory");
        __syncthreads();
        if (wave == 0 && lane == 0) xb_add(flag, 1u);
        for (int t = gw; t < 2048; t += NGW) sb_task_mfma(PROJ, MIXRAW, (float*)(ws + SSQ_SB), wl, t & 3, 32 * (t >> 2), lane);
        __syncthreads();
        if (G == 256) { const int v = bx >> 3; ca_unit(PROJ, A->in[7] + (size_t)l * 8 * 257, MIXRAW, (float*)(ws + SSQ_CA), lds, v & 7, 32 * (bx & 7) + 4 * (v >> 3), wave, lane, tid); }
        __syncthreads();
        { unsigned sp_ = 0; while (xb_ld(flag) < (unsigned)G) { __builtin_amdgcn_s_sleep(2); if (++sp_ > (1u << 22)) break; } }
        asm volatile("" ::: "memory");
        for (int t = gw; t < 2048; t += NGW) ssm_c2_task(PROJ, sp, (const float2*)(ws + TAB_A), (const bf16*)(ws + TAB_B), (const float2*)(ws + WS_SEND), (bf16*)(ws + WS_YG), wl, l * 16 + (t & 15), t & 15, t >> 4, lane);
        asm volatile("s_waitcnt vmcnt(0)" ::: "memory");
        __syncthreads();
        if (wave == 0 && lane == 0) xb_add(flag + 32, 1u);
        if (G == 256) { const int v = 32 + (bx >> 3); ca_unit(PROJ, A->in[7] + (size_t)l * 8 * 257, MIXRAW, (float*)(ws + SSQ_CA), lds, v & 7, 32 * (bx & 7) + 4 * (v >> 3), wave, lane, tid); }
        __syncthreads();
        { unsigned sp_ = 0; while (xb_ld(flag + 32) < (unsigned)G) { __builtin_amdgcn_s_sleep(2); if (++sp_ > (1u << 22)) break; } }
        asm volatile("" ::: "memory");
        { CArgs A2 = LARGS(); unsigned char* ws2 = A2->ws;
          pg8::Gemm g{(const bf16*)(ws2 + WS_YG), (const bf16*)(ws2 + WS_WGLU + l * WGLU_BYTES), S, 512, 256, nullptr, 0, PTID()}; pg8::StaticOrder So; So.init(S, 512, gridDim.x, blockIdx.x, WGM_GLU);
          pg8::EpiGated<0> E{(bf16*)(ws2 + WS_MIXRAW), D, 0, nullptr, (float*)(ws2 + SSQ_SSM), nullptr};
          pg8::gemm_phase<pg8::EpiGated<0>, pg8::StaticOrder, true, true>(lds, g, So, E); }
        FILL_SHORT((S / 256) * 2, FILL_GLU);
        SEAM(); PH_END(3);
    }
    if (IN(1 + lraw * PH_PER_LAYER + 6)) { PH_BEGIN(7);
        CArgs A = LARGS(); const int l = LINT(lraw); unsigned char* ws = A->ws;
        pg8::Gemm g{(const bf16*)(ws + WS_MIXRAW), (const bf16*)(ws + WS_WOUT + l * WOUT_BYTES), S, D, D, nullptr, 0, PTID()}; pg8::StaticOrder So; So.init(S, D, gridDim.x, blockIdx.x, WGM_OUT);
        LAS float* fac = (LAS float*)(lds + MISC_OFF + 256);
        { pg8::Unit u0; const int tid = PTID(); if (So.first_unit(u0) && tid < 256) {
              const size_t row = (size_t)u0.pm * 256 + tid;
              const float rs = rsqrtf(pg8::sum8f((const float*)(ws + SSQ_SSM) + row * 8) * (1.f / 256.f) + 1e-6f), rb = rsqrtf(pg8::sum4f((const float*)(ws + SSQ_SB) + row * 4) * (1.f / 256.f) + 1e-6f),
                          rc = rsqrtf(pg8::sum8f((const float*)(ws + SSQ_CA) + row * 8) * (1.f / 512.f) + 1e-6f);
              fac[tid] = rs / rb; fac[256 + tid] = rb / rc; fac[512 + tid] = rc; }
          __syncthreads(); }
        pg8::EpiResidual<true> E{A->out, lraw == 0 ? A->in[0] : A->out, D, 1.f, (bf16*)(ws + WS_H), (float*)(ws + SS_B), fac};
        pg8::gemm_phase<pg8::EpiResidual<true>, pg8::StaticOrder, true, true>(lds, g, So, E);
        if (!MOE) { WAVE_IDS(); DRAIN(lraw == 0 ? CV_F0 : CV_F1); }
        SEAM(); PH_END(7);
    }
    if (!MOE) {
        if (IN(1 + lraw * PH_PER_LAYER + 8)) { PH_BEGIN(10);
            CArgs A = LARGS(); const int l = LINT(lraw); unsigned char* ws = A->ws; const int fidx = l >> 1;
            pg8::Gemm g{(const bf16*)(ws + WS_H), (const bf16*)(ws + WS_GU + fidx * GU_BYTES), S, 2 * DFF, D, nullptr, 0, PTID()}; pg8::StaticOrder So; So.init(S, 2 * DFF, gridDim.x, blockIdx.x, WGM_GUD);
            pg8::EpiGated<1, 2> E{(bf16*)(ws + WS_R1), DFF, 0, nullptr, nullptr, (const LAS float*)(lds + RS_OFF)};
            RS_PREPASS(So, (const float*)(ws + SS_B));
            pg8::gemm_phase<pg8::EpiGated<1, 2>, pg8::StaticOrder, true, true>(lds, g, So, E);
            FILL_SHORT((S / 256) * (2 * DFF / 256), FILL_B1);
            SEAM(); PH_END(10);
        }
        if (IN(1 + lraw * PH_PER_LAYER + 9)) { PH_BEGIN(11);
            CArgs A = LARGS(); const int l = LINT(lraw); unsigned char* ws = A->ws; const int fidx = l >> 1;
            pg8::Gemm g{(const bf16*)(ws + WS_R1), (const bf16*)(ws + WS_DN + fidx * DN_BYTES), S, D, DFF, nullptr, 0, PTID()}; pg8::StaticOrder So; So.init(S, D, gridDim.x, blockIdx.x, WGM_DND);
            pg8::EpiResidual<false> E{A->out, A->out, D, 1.f, (bf16*)(ws + WS_H), (float*)(ws + SS_A), nullptr};
            pg8::gemm_phase<pg8::EpiResidual<false>, pg8::StaticOrder, true, true>(lds, g, So, E);
            { WAVE_IDS(); DRAIN(CVB_NEXT); }
            SEAM(); PH_END(11);
        }
    } else {
        if (IN(1 + lraw * PH_PER_LAYER + 7)) { PH_BEGIN(9);
            WAVE_IDS(); CArgs A = LARGS(); const int l = LINT(lraw); unsigned char* ws = A->ws;
            int r_row, r_e0, r_e1, r_p0, r_p1; float r_r;
            route_phase(A->out, A->in[19] + (size_t)l * D, A->in[23] + (size_t)(l >> 1) * D * 8, (int*)(ws + WS_CTL) + CW_WGCNT, (float*)(ws + WS_TOKG), gw, NGW, lane, (LAS float*)lds, tid, r_row, r_e0, r_e1, r_p0, r_p1, r_r);
            unsigned* flag = (unsigned*)(ws + WS_CTL) + CW_SSMF + 64 * l + 16;
            asm volatile("s_waitcnt vmcnt(0)" ::: "memory");
            __syncthreads();
            if (wave == 0 && lane == 0) xb_add(flag, 1u);
            DRAIN(lraw == 1 ? CV_M1 : CV_M3);
            { unsigned sp_ = 0; while (xb_ld(flag) < (unsigned)G) { __builtin_amdgcn_s_sleep(2); if (++sp_ > (1u << 22)) break; } }
            asm volatile("" ::: "memory");
            { CArgs A2 = LARGS(); unsigned char* ws2 = A2->ws;
              perm_phase((int*)(ws2 + WS_CTL) + CW_MOE + (l >> 1) * MOE_WORDS, (const int*)(ws2 + WS_CTL) + CW_WGCNT, (int*)(ws2 + WS_TOKSLOT), (int*)(ws2 + WS_SLOTTOK), (float*)(ws2 + SLOT_RS), (LAS int*)lds, gw, lane, tid, r_row, r_e0, r_e1, r_p0, r_p1, r_r); }
            SEAM(); PH_END(9);
        }
        if (IN(1 + lraw * PH_PER_LAYER + 9)) { PH_BEGIN(13);
            CArgs A = LARGS(); const int l = LINT(lraw); unsigned char* ws = A->ws; const int fidx = 2 + NEXP * (l >> 1);
            const int* mctl = (const int*)(ws + WS_CTL) + CW_MOE + (l >> 1) * MOE_WORDS; const int nt = mctl[16];
            pg8::Gemm g{(const bf16*)(ws + WS_H), (const bf16*)(ws + WS_GU + fidx * GU_BYTES), nt * 256, 2 * DFF, D, mctl + 32, GU_BYTES, PTID(), 0, (const int*)(ws + WS_SLOTTOK)}; pg8::StaticOrder So; So.init(nt * 256, 2 * DFF, gridDim.x, blockIdx.x, WGM_GUM);
            pg8::EpiGated<1, 1> E{(bf16*)(ws + WS_R1), DFF, 0, (const float*)(ws + SLOT_RS), nullptr, nullptr};
            pg8::gemm_phase<pg8::EpiGated<1, 1>, pg8::StaticOrder, true, true>(lds, g, So, E);
            FILL_SHORT(nt * (2 * DFF / 256), FILL_B1);
            SEAM(); PH_END(13);
        }
        if (IN(1 + lraw * PH_PER_LAYER + 10)) { PH_BEGIN(14);
            CArgs A = LARGS(); const int l = LINT(lraw); unsigned char* ws = A->ws; const int fidx = 2 + NEXP * (l >> 1);
            const int* mctl = (const int*)(ws + WS_CTL) + CW_MOE + (l >> 1) * MOE_WORDS; const int nt = mctl[16];
            pg8::Gemm g{(const bf16*)(ws + WS_R1), (const bf16*)(ws + WS_DN + fidx * DN_BYTES), nt * 256, D, DFF, mctl + 32, DN_BYTES, PTID()}; pg8::StaticOrder So; So.init(nt * 256, D, gridDim.x, blockIdx.x, WGM_DNM);
            pg8::EpiStoreBf16 E{(bf16*)(ws + WS_R2), D, (bf16*)(ws + WS_Y2)};
            const int units = nt * (D / 256);
            if (gridDim.x == 256 && units > 512) {
                So.limit = 512;
                pg8::gemm_phase<pg8::EpiStoreBf16, pg8::StaticOrder, true, true>(lds, g, So, E);
                pg8::LeftoverOrder Lo; Lo.init(nt * 256, D, gridDim.x, blockIdx.x, 512, WGM_DNM); pg8::Gemm g2 = g; g2.Klen = DFF / 2; g2.tid = PTID();
                pg8::gemm_phase<pg8::EpiStoreBf16, pg8::LeftoverOrder, true, true>(lds, g2, Lo, E);
                if (lraw == 1) { FILL_SHORT(2 * (units - 512) < 256 ? 2 * (units - 512) : 0, FILL_MDN2); }
            } else {
                pg8::gemm_phase<pg8::EpiStoreBf16, pg8::StaticOrder, true, true>(lds, g, So, E);
                if (lraw == 1) { FILL_SHORT(units, FILL_MDN); }
            }
            if (lraw == 1) { WAVE_IDS(); DRAIN(CVB_NEXT); }
            SEAM(); PH_END(14);
        }
    }
}

__global__ void __launch_bounds__(NWAVES * 64, 2) mk_fwd(Args args_unused) {
    extern __shared__ __attribute__((aligned(16))) unsigned char lds_raw[];
    LAS unsigned char* lds = (LAS unsigned char*)lds_raw;
    volatile LAS unsigned* MISC = (volatile LAS unsigned*)(lds + MISC_OFF);
    if (threadIdx.x < 32) MISC[threadIdx.x] = 0u;
    __syncthreads();
    const int wave_s = __builtin_amdgcn_readfirstlane(threadIdx.x >> 6);
    XcdBarrier bar; { CArgs A = LARGS(); bar.bar = (unsigned*)(A->ws + WS_CTL) + CW_BAR; bar.x = 0; bar.st = nullptr; if (ONE_LAUNCH) bar = xcd_barrier_post((unsigned*)(A->ws + WS_CTL) + CW_BAR, MISC + 8); bar.wv = wave_s; }
    int cvc = 0;
    if (IN(0)) { PH_BEGIN(0); WAVE_IDS(); CArgs A = LARGS(); conv_drain(A, cvc, CV_B0, (LAS float*)wl, wave, lane);
        if (gw < 64) { const int l = gw >> 4, g = gw & 15; unsigned char* ws = A->ws;
            SsmPar sp{A->in[8] + l * 1024, A->in[9] + l * 1024, A->in[10] + l * 16, A->in[11] + (size_t)l * 16384, A->in[12] + (size_t)l * 16384, A->in[13] + (size_t)l * 16384, A->in[14] + (size_t)l * 16384, A->in[15] + l * 256};
            ssm_table_task(sp, (float2*)(ws + TAB_A), (bf16*)(ws + TAB_B), gw, g, lane); } PH_END(0); }

    layer_body<0>(lds, bar, wave_s, cvc); layer_body<1>(lds, bar, wave_s, cvc); layer_body<2>(lds, bar, wave_s, cvc); layer_body<3>(lds, bar, wave_s, cvc);
    if (IN(N_PHASES - 1)) { WAVE_IDS(); CArgs A = LARGS(); unsigned char* ws = A->ws;
        row_phase(A->out, A->out, true, (const bf16*)(ws + WS_R2), (const bf16*)(ws + WS_Y2), (const int*)(ws + WS_CTL) + CW_MOE + 1 * MOE_WORDS + 256, (const int*)(ws + WS_TOKSLOT), (const float*)(ws + WS_TOKG), nullptr, nullptr, gw, NGW, lane); }
#undef IN
#undef SEAM
}

extern "C" void kernel_launch(void* const* d_in, const int* in_sizes, int n_in, void* d_out, int out_size, void* d_ws, size_t ws_size, hipStream_t stream) {
    static int grid = 0;
    if (grid == 0) {
        if (n_in != 27 || out_size != S * D || ws_size < WS_END) { fprintf(stderr, "kernel_launch: unexpected problem (n_in %d, out %d, ws %zu)\n", n_in, out_size, ws_size); grid = -1; return; }
        int dev = 0, cus = 0, per_cu = 0;
        if (hipGetDevice(&dev) != hipSuccess || hipDeviceGetAttribute(&cus, hipDeviceAttributeMultiprocessorCount, dev) != hipSuccess) { grid = -1; return; }
        if (hipFuncSetAttribute((const void*)mk_fwd, hipFuncAttributeMaxDynamicSharedMemorySize, LDS_BYTES) != hipSuccess) { fprintf(stderr, "kernel_launch: hipFuncSetAttribute failed\n"); grid = -1; return; }
        if (hipOccupancyMaxActiveBlocksPerMultiprocessor(&per_cu, (const void*)mk_fwd, NWAVES * 64, LDS_BYTES) != hipSuccess || per_cu < 1) { fprintf(stderr, "kernel_launch: occupancy query says %d\n", per_cu); }
        (void)hipGetLastError();
        if (cus < 256 || per_cu < 1) { fprintf(stderr, "kernel_launch: needs 256 CUs with one resident 512-thread workgroup each (have %d CUs, %d per CU)\n", cus, per_cu); grid = -1; return; }
        grid = 256;
    }
    if (grid < 0) return;
    if (hipMemsetAsync((char*)d_ws + WS_CTL, 0, CTL_ZERO_BYTES, stream) != hipSuccess) return;
    Args a{};
    for (int i = 0; i < 27; ++i) a.in[i] = (const float*)d_in[i];
    a.out = (float*)d_out; a.ws = (unsigned char*)d_ws;
    if (ONE_LAUNCH) {
        a.ph_lo = 0; a.ph_hi = N_PHASES;
        hipLaunchKernelGGL(mk_fwd, dim3(grid), dim3(NWAVES * 64), LDS_BYTES, stream, a);
    } else {
        for (int p = 0; p < N_PHASES; ++p) {
            if (p >= 1 && p < N_PHASES - 1) { const int l = (p - 1) / PH_PER_LAYER, k = (p - 1) % PH_PER_LAYER; const bool moe = l & 1;
                if (k == 5 || (k == 0 && moe) || (k == 7 && !moe) || (k == 10 && !moe)) continue; }
            a.ph_lo = p; a.ph_hi = p + 1;
            hipLaunchKernelGGL(mk_fwd, dim3(grid), dim3(NWAVES * 64), LDS_BYTES, stream, a);
        }
    }
}
```

```cpp
#include <hip/hip_runtime.h>
#include <cstdio>
#include <cstdint>
namespace pg8 {
#define PG8_LAS __attribute__((address_space(3)))
typedef unsigned short bf16_t;
typedef short bf16x8 __attribute__((ext_vector_type(8)));
typedef float f32x4 __attribute__((ext_vector_type(4)));
typedef unsigned u32x4 __attribute__((ext_vector_type(4)));
constexpr int BM = 256, BK = 64, HALF = 128, HTB = HALF * BK * 2  , STAGE_BYTES = 8 * HTB, NXCD = 8, WGM_DEFAULT = 4;

__host__ __device__ __forceinline__ int lds_byte(int r, int c) { const int st = (r >> 4) * 2 + (c >> 5), rr = r & 15, cc = c & 31, ob = rr * 64 + cc * 2; return st * 1024 + (ob ^ (((ob >> 9) & 1) << 5)); }
__host__ __device__ __forceinline__ void stage_rc(int b, int& R, int& C) { const int st = b / 1024, sb = b % 1024, swz = sb ^ (((sb >> 9) & 1) << 5); R = (st >> 1) * 16 + swz / 64; C = (st & 1) * 32 + (swz % 64) / 2; }
__host__ __device__ __forceinline__ int perm32(int rho) { const int n = rho >> 4, i = rho & 15; return 8 * (i >> 2) + 4 * n + (i & 3); }

struct Unit { int pm, pn, half, ord; };
struct Gemm { const bf16_t* A; const bf16_t* Bt; int M, N, K; const int* tile_e; size_t estride; int tid; int Klen; const int* gidx; };

struct StaticOrder {
    int nM, nN, nwg, G, c, limit, WGM;
    __host__ __device__ void init(int M, int N, int G_, int c_, int wgm = WGM_DEFAULT) { nM = M / BM; nN = N / BM; nwg = nM * nN; G = G_; c = c_; limit = nwg; WGM = wgm; }
    __host__ __device__ bool next(int i, Unit& u) const {
        const long L = (long)i * G + c; if (L >= limit) return false; u.half = 0; u.ord = i;
        int wgid = (int)L; { const int q = nwg / NXCD, r = nwg % NXCD, xcd = wgid % NXCD, off = wgid / NXCD; wgid = (xcd < r ? xcd * (q + 1) : r * (q + 1) + (xcd - r) * q) + off; }
        const int nig = WGM * nN, gid = wgid / nig, fm = gid * WGM, gsz = (nM - fm) < WGM ? (nM - fm) : WGM;
        u.pm = fm + ((wgid % nig) % gsz); u.pn = (wgid % nig) / gsz; return true;
    }
    __device__ __forceinline__ bool first_unit(Unit& u) const {
        if (c >= nwg) return false; u.half = 0; u.ord = 0;
        int wgid = c; { const int q = nwg / NXCD, r = nwg % NXCD, xcd = wgid % NXCD, off = wgid / NXCD; wgid = (xcd < r ? xcd * (q + 1) : r * (q + 1) + (xcd - r) * q) + off; }
        const int nig = WGM * nN, gid = wgid / nig, fm = gid * WGM, gsz = (nM - fm) < WGM ? (nM - fm) : WGM;
        u.pm = fm + ((wgid % nig) % gsz); u.pn = (wgid % nig) / gsz; return true;
    }
    __device__ __forceinline__ void a_ready(const Unit&) const {}
    __device__ __forceinline__ void done(const Unit&) const {}
    __host__ __device__ __forceinline__ void unit_of(int L, Unit& u) const {
        int wgid = L; { const int q = nwg / NXCD, r = nwg % NXCD, xcd = wgid % NXCD, off = wgid / NXCD; wgid = (xcd < r ? xcd * (q + 1) : r * (q + 1) + (xcd - r) * q) + off; }
        const int nig = WGM * nN, gid = wgid / nig, fm = gid * WGM, gsz = (nM - fm) < WGM ? (nM - fm) : WGM;
        u.pm = fm + ((wgid % nig) % gsz); u.pn = (wgid % nig) / gsz;
    }
};
struct LeftoverOrder {
    StaticOrder so; int base;
    __host__ __device__ void init(int M, int N, int G_, int c_, int base_, int wgm = WGM_DEFAULT) { so.init(M, N, G_, c_, wgm); base = base_; }
    __host__ __device__ bool next(int i, Unit& u) const {
        const int j = i * so.G + so.c; if (j >= 2 * (so.nwg - base)) return false;
        so.unit_of(base + (j >> 1), u); u.half = j & 1; u.ord = i; return true;
    }
    __device__ __forceinline__ void a_ready(const Unit&) const {}
    __device__ __forceinline__ void done(const Unit&) const {}
};

__device__ __forceinline__ unsigned cvt_pk_bf16(float lo, float hi) { unsigned r; asm volatile("v_cvt_pk_bf16_f32 %0, %1, %2" : "=v"(r) : "v"(lo), "v"(hi)); return r; }
__device__ __forceinline__ u32x4 pack8(const f32x4& a, const f32x4& b) { u32x4 w; w.x = cvt_pk_bf16(a[0], a[1]); w.y = cvt_pk_bf16(a[2], a[3]); w.z = cvt_pk_bf16(b[0], b[1]); w.w = cvt_pk_bf16(b[2], b[3]); return w; }

__device__ __forceinline__ float sum4f(const float* p) { const f32x4 a = *(const f32x4*)p; return (a[0] + a[1]) + (a[2] + a[3]); }
__device__ __forceinline__ float sum8f(const float* p) { return sum4f(p) + sum4f(p + 4); }
__device__ __forceinline__ float sum16f(const float* p) { return sum8f(p) + sum8f(p + 8); }
__device__ __forceinline__ float row_sum16(const float* base16, int fq) { float s = sum4f(base16 + 4 * fq); s += __shfl_xor(s, 16); s += __shfl_xor(s, 32); return s; }
__device__ __forceinline__ void rows_rstd16(float (&r)[2][4], const float* ss16, int row0  , int fq) {
    f32x4 pv[2][4];
#pragma unroll
    for (int ai = 0; ai < 2; ++ai)
#pragma unroll
        for (int m = 0; m < 4; ++m) pv[ai][m] = *(const f32x4*)(ss16 + (size_t)(row0 + ai * HALF + m * 16) * 16 + 4 * fq);
#pragma unroll
    for (int ai = 0; ai < 2; ++ai)
#pragma unroll
        for (int m = 0; m < 4; ++m) { float s = (pv[ai][m][0] + pv[ai][m][1]) + (pv[ai][m][2] + pv[ai][m][3]); s += __shfl_xor(s, 16); s += __shfl_xor(s, 32); r[ai][m] = rsqrtf(s * (1.f / 1024.f) + 1e-6f); }
}
struct EpiInProj {
    static constexpr bool PERM = true, AFTER_DRAIN = false;
    static constexpr bool KHOOK = false, GATHER = false;
    bf16_t* P; const float *gq_sb, *gk_sb, *gq_ca, *gk_ca; float qscale; const PG8_LAS float* rs_lds; int ppitch;
    __device__ __forceinline__ void operator()(const f32x4 (&acc)[2][2][4][2], const Unit& u, int wr, int wc, int fr, int fq) const {
        const int pn = u.pn; const float* g = nullptr; float gs = 1.f;
        if (pn == 0) { g = gq_sb; gs = qscale; } else if (pn == 1) { g = gk_sb; } else if (pn == 3 || pn == 4) { g = gq_ca; gs = qscale; } else if (pn == 5 || pn == 6) { g = gk_ca; }
        bf16_t* base = P + (size_t)(u.pm * BM + wr * 64 + fr) * ppitch + pn * 256 + wc * 64 + fq * 8;
        float r0s[2][4];
#pragma unroll
        for (int ai = 0; ai < 2; ++ai)
#pragma unroll
            for (int m = 0; m < 4; ++m) r0s[ai][m] = rs_lds[u.ord * 256 + ai * HALF + wr * 64 + m * 16 + fr];
        if (g) {
            f32x4 gv[2][2];
#pragma unroll
            for (int bj = 0; bj < 2; ++bj)
#pragma unroll
                for (int n = 0; n < 2; ++n) gv[bj][n] = *(const f32x4*)(g + 32 * bj + 8 * fq + 4 * n) * gs;
#pragma unroll
            for (int ai = 0; ai < 2; ++ai)
#pragma unroll
                for (int m = 0; m < 4; ++m) {
                    const float r0 = r0s[ai][m];
                    float ss = 0.f;
#pragma unroll
                    for (int bj = 0; bj < 2; ++bj)
#pragma unroll
                        for (int n = 0; n < 2; ++n) { const f32x4 v = acc[ai][bj][m][n]; ss += v[0] * v[0] + v[1] * v[1] + v[2] * v[2] + v[3] * v[3]; }
                    ss += __shfl_xor(ss, 16); ss += __shfl_xor(ss, 32);
                    const float r = r0 * rsqrtf(ss * (r0 * r0) * (1.f / 64.f) + 1e-6f);
                    bf16_t* rowp = base + (size_t)(ai * HALF + m * 16) * ppitch;
#pragma unroll
                    for (int bj = 0; bj < 2; ++bj) *(u32x4*)(rowp + bj * 32) = pack8(acc[ai][bj][m][0] * r * gv[bj][0], acc[ai][bj][m][1] * r * gv[bj][1]);
                }
        } else {
#pragma unroll
            for (int ai = 0; ai < 2; ++ai)
#pragma unroll
                for (int m = 0; m < 4; ++m) { bf16_t* rowp = base + (size_t)(ai * HALF + m * 16) * ppitch;
                    const float r0 = r0s[ai][m];
#pragma unroll
                    for (int bj = 0; bj < 2; ++bj) *(u32x4*)(rowp + bj * 32) = pack8(acc[ai][bj][m][0] * r0, acc[ai][bj][m][1] * r0); }
        }
    }
};
template <int KIND, int RSMODE = 0> struct EpiGated {
    static constexpr bool PERM = true, AFTER_DRAIN = false, KHOOK = false, GATHER = (KIND == 1 && RSMODE == 1);
    bf16_t* O; int ldc; int col0; const float* rs; float* ssq; const PG8_LAS float* rs_lds;
    __device__ __forceinline__ void operator()(const f32x4 (&acc)[2][2][4][2], const Unit& u, int wr, int wc, int fr, int fq) const {
        float rrs[2][4];
        if (KIND == 1) { if (RSMODE == 0) rows_rstd16(rrs, rs, u.pm * BM + wr * 64 + fr, fq); else if (RSMODE == 2) {
#pragma unroll
            for (int ai = 0; ai < 2; ++ai)
#pragma unroll
                for (int m = 0; m < 4; ++m) rrs[ai][m] = rs_lds[u.ord * 256 + ai * HALF + wr * 64 + m * 16 + fr]; } else {
#pragma unroll
            for (int ai = 0; ai < 2; ++ai)
#pragma unroll
                for (int m = 0; m < 4; ++m) rrs[ai][m] = rs[u.pm * BM + ai * HALF + wr * 64 + m * 16 + fr]; } }
#pragma unroll
        for (int ai = 0; ai < 2; ++ai)
#pragma unroll
            for (int m = 0; m < 4; ++m) {
                const int row = u.pm * BM + ai * HALF + wr * 64 + m * 16 + fr;
                float rr = 1.f;
                if (KIND == 1) rr = rrs[ai][m];
                f32x4 r[2]; float sq = 0.f;
#pragma unroll
                for (int n = 0; n < 2; ++n)
#pragma unroll
                    for (int e = 0; e < 4; ++e) { const float a = acc[ai][0][m][n][e] * rr, b = acc[ai][1][m][n][e] * rr;
                        const float o = (KIND == 0) ? a * __builtin_amdgcn_rcpf(1.f + __expf(-b)) : a * __builtin_amdgcn_rcpf(1.f + __expf(-a)) * b; r[n][e] = o; sq += o * o; }
                *(u32x4*)(O + (size_t)row * ldc + col0 + u.pn * 128 + wc * 32 + fq * 8) = pack8(r[0], r[1]);
                if (KIND == 0) { sq += __shfl_xor(sq, 16); sq += __shfl_xor(sq, 32); if (fq == 0) ssq[(size_t)row * 8 + u.pn * 4 + wc] = sq; }
            }
    }
};
template <bool HOOKED> struct EpiResidual {
    static constexpr bool PERM = true, AFTER_DRAIN = false, KHOOK = HOOKED, GATHER = false;
    float* X; const float* Xsrc; int ldc; float scale; bf16_t* XB; float* ss_out; const PG8_LAS float* fac;
    __device__ __forceinline__ void khook(int t, f32x4 (&acc)[2][2][4][2], const Unit& u, int wr, int fr) const {
        if (t != 4 && t != 8) return;
        const PG8_LAS float* fp = fac + (t == 4 ? 0 : 256) + wr * 64 + fr;
#pragma unroll
        for (int ai = 0; ai < 2; ++ai)
#pragma unroll
            for (int m = 0; m < 4; ++m) {
                const float f = fp[ai * HALF + m * 16];
#pragma unroll
                for (int bj = 0; bj < 2; ++bj)
#pragma unroll
                    for (int n = 0; n < 2; ++n) acc[ai][bj][m][n] = acc[ai][bj][m][n] * f;
            }
    }
    __device__ __forceinline__ void operator()(const f32x4 (&acc)[2][2][4][2], const Unit& u, int wr, int wc, int fr, int fq) const {
#pragma unroll
        for (int ai = 0; ai < 2; ++ai)
#pragma unroll
            for (int m = 0; m < 4; ++m) {
                const int row = u.pm * BM + ai * HALF + wr * 64 + m * 16 + fr;
                float sc = scale; if (HOOKED) sc *= fac[512 + ai * HALF + wr * 64 + m * 16 + fr];
                float sq = 0.f;
#pragma unroll
                for (int bj = 0; bj < 2; ++bj) { const size_t off = (size_t)row * ldc + u.pn * BM + bj * HALF + wc * 32 + fq * 8; f32x4* p = (f32x4*)(X + off); const f32x4* ps = (const f32x4*)(Xsrc + off);
                    const f32x4 a = ps[0] + acc[ai][bj][m][0] * sc, b = ps[1] + acc[ai][bj][m][1] * sc; p[0] = a; p[1] = b;
                    *(u32x4*)(XB + off) = pack8(a, b);
                    sq += a[0] * a[0] + a[1] * a[1] + a[2] * a[2] + a[3] * a[3] + b[0] * b[0] + b[1] * b[1] + b[2] * b[2] + b[3] * b[3]; }
                sq += __shfl_xor(sq, 16); sq += __shfl_xor(sq, 32);
                if (fq == 0) ss_out[(size_t)row * 16 + u.pn * 4 + wc] = sq;
            }
    }
};
struct EpiStoreBf16 {
    static constexpr bool PERM = true, AFTER_DRAIN = false, KHOOK = false, GATHER = false;
    bf16_t* O; int ldc; bf16_t* O2;
    __device__ __forceinline__ void operator()(const f32x4 (&acc)[2][2][4][2], const Unit& u, int wr, int wc, int fr, int fq) const {
        bf16_t* Ob = u.half ? O2 : O;
#pragma unroll
        for (int ai = 0; ai < 2; ++ai)
#pragma unroll
            for (int m = 0; m < 4; ++m) {
                const int row = u.pm * BM + ai * HALF + wr * 64 + m * 16 + fr;
#pragma unroll
                for (int bj = 0; bj < 2; ++bj) *(u32x4*)(Ob + (size_t)row * ldc + u.pn * BM + bj * HALF + wc * 32 + fq * 8) = pack8(acc[ai][bj][m][0], acc[ai][bj][m][1]);
            }
    }
};
template <class Epi, class Sched, bool ALIGN_EPI = false, bool SP2 = false>
__device__ __forceinline__ void gemm_phase(PG8_LAS unsigned char* lds, const Gemm g, const Sched& S, const Epi& E) {
    int tid_ = g.tid; asm volatile("" : "+v"(tid_));
    const int tid = tid_, wid = __builtin_amdgcn_readfirstlane(tid >> 6), lane = tid & 63, wr = wid >> 2, wc = wid & 3, fr = lane & 15, fq = lane >> 4;
    const int K = g.K, klen = g.Klen ? g.Klen : g.K, nt = klen / BK;
    const size_t hoff = (size_t)klen * 2;
    unsigned voffA[2], voffB[2];
#pragma unroll
    for (int i = 0; i < 2; ++i) { int R, C; stage_rc(tid * 16 + i * 8192, R, C); const int Rb = Epi::PERM ? ((R & ~31) + perm32(R & 31)) : R;
        voffA[i] = (unsigned)(R * K + C) * 2u; voffB[i] = (unsigned)(Rb * K + C) * 2u; }
    constexpr bool GA = Epi::GATHER; static_assert(!GA || SP2, "gather is wired into the SP2 loop only");
    unsigned vc0[2] = {0u, 0u}, vc1[2] = {0u, 0u}, vn0[2] = {0u, 0u}, vn1[2] = {0u, 0u};
#define PG8_GOFF(d0, d1, pm_) do { _Pragma("unroll") for (int _i = 0; _i < 2; ++_i) { int R_, C_; stage_rc(tid * 16 + _i * 8192, R_, C_); const int* gp_ = g.gidx + (pm_) * 256 + R_; \
        d0[_i] = ((unsigned)gp_[0] * (unsigned)K + (unsigned)C_) * 2u; d1[_i] = ((unsigned)gp_[HALF] * (unsigned)K + (unsigned)C_) * 2u; } } while (0)
    const size_t kstep = (size_t)(BK * 2);
    const size_t hstep = (size_t)HALF * K * 2;
    const size_t tstep = 2 * hstep;
    const unsigned ldsw = (unsigned)wid * 1024u;
    const int aoff = lds_byte(wr * 64 + fr, fq * 8), boff = lds_byte(wc * 32 + fr, fq * 8);
#define PG8_SA(b, h) (((b) * 2 + (h)) * HTB)
#define PG8_SB(b, h) ((4 + (b) * 2 + (h)) * HTB)
#define PG8_STAGE(bufoff, gbase, voff) do { _Pragma("unroll") for (int _i = 0; _i < 2; ++_i) \
        __builtin_amdgcn_global_load_lds((const unsigned*)((const char*)(gbase) + (voff)[_i]), (PG8_LAS unsigned*)(lds + (bufoff) + ldsw + _i * 8192), 16, 0, 0); } while (0)
#define PG8_LDA(dst, b, h) do { _Pragma("unroll") for (int m = 0; m < 4; ++m) _Pragma("unroll") for (int k = 0; k < 2; ++k) dst[m][k] = *(const PG8_LAS bf16x8*)(lds + PG8_SA(b, h) + aoff + m * 2048 + k * 1024); } while (0)
#define PG8_LDB(dst, b, h) do { _Pragma("unroll") for (int n = 0; n < 2; ++n) _Pragma("unroll") for (int k = 0; k < 2; ++k) dst[n][k] = *(const PG8_LAS bf16x8*)(lds + PG8_SB(b, h) + boff + n * 2048 + k * 1024); } while (0)
#define PG8_MMA(ai, bj, At, Bt) do { __builtin_amdgcn_s_setprio(1); _Pragma("unroll") for (int m = 0; m < 4; ++m) _Pragma("unroll") for (int n = 0; n < 2; ++n) _Pragma("unroll") for (int k = 0; k < 2; ++k) \
        acc[ai][bj][m][n] = __builtin_amdgcn_mfma_f32_16x16x32_bf16(Bt[n][k], At[m][k], acc[ai][bj][m][n], 0, 0, 0); __builtin_amdgcn_s_setprio(0); } while (0)
#define PG8_WAIT_V(n) asm volatile("s_waitcnt vmcnt(" #n ")" ::: "memory")
#define PG8_WAIT_L(n) asm volatile("s_waitcnt lgkmcnt(" #n ")" ::: "memory")
#define PG8_BAR __builtin_amdgcn_s_barrier()
#define PG8_SCHED __builtin_amdgcn_sched_barrier(0)
    Unit cur, nxt; int ui = 0;
    if (!S.next(0, cur)) return;
    f32x4 acc[2][2][4][2];
#pragma unroll
    for (int a = 0; a < 2; ++a)
#pragma unroll
        for (int b = 0; b < 2; ++b)
#pragma unroll
            for (int m = 0; m < 4; ++m)
#pragma unroll
                for (int n = 0; n < 2; ++n) acc[a][b][m][n] = (f32x4){0.f, 0.f, 0.f, 0.f};
    bf16x8 At[4][2], B0[2][2], B1[2][2];
    const char* cA = (const char*)g.A + (GA ? (size_t)0 : (size_t)cur.pm * tstep) + cur.half * hoff;
    if constexpr (GA) PG8_GOFF(vc0, vc1, cur.pm);
    const char* cB = (const char*)g.Bt + (g.tile_e ? (size_t)g.tile_e[cur.pm] * g.estride : (size_t)0) + (size_t)cur.pn * tstep + cur.half * hoff;
    S.a_ready(cur);
    if constexpr (SP2) {
        PG8_STAGE(PG8_SB(0, 0), cB, voffB); PG8_STAGE(PG8_SB(0, 1), cB + hstep, voffB);
        if constexpr (GA) { PG8_STAGE(PG8_SA(0, 0), cA, vc0); PG8_STAGE(PG8_SA(0, 1), cA, vc1); } else { PG8_STAGE(PG8_SA(0, 0), cA, voffA); PG8_STAGE(PG8_SA(0, 1), cA + hstep, voffA); }
        if (wr == 1) PG8_BAR;
        PG8_WAIT_V(2); PG8_BAR;
        PG8_STAGE(PG8_SB(1, 0), cB + kstep, voffB); if constexpr (GA) PG8_STAGE(PG8_SA(1, 0), cA + kstep, vc0); else PG8_STAGE(PG8_SA(1, 0), cA + kstep, voffA); PG8_STAGE(PG8_SB(1, 1), cB + hstep + kstep, voffB);
        PG8_WAIT_V(6); PG8_BAR;
    } else {
        PG8_STAGE(PG8_SB(0, 0), cB, voffB); PG8_STAGE(PG8_SA(0, 0), cA, voffA); PG8_STAGE(PG8_SB(0, 1), cB + hstep, voffB); PG8_STAGE(PG8_SA(0, 1), cA + hstep, voffA);
        if (wr == 1) PG8_BAR;
        PG8_WAIT_V(4); PG8_BAR;
        PG8_STAGE(PG8_SB(1, 0), cB + kstep, voffB); PG8_STAGE(PG8_SA(1, 0), cA + kstep, voffA); PG8_STAGE(PG8_SB(1, 1), cB + hstep + kstep, voffB);
        PG8_WAIT_V(6); PG8_BAR;
    }
    for (;;) {
        const bool has_next = S.next(ui + 1, nxt);
        if constexpr (GA) { if (has_next) PG8_GOFF(vn0, vn1, nxt.pm); else { vn0[0] = vc0[0]; vn0[1] = vc0[1]; vn1[0] = vc1[0]; vn1[1] = vc1[1]; } }
        const char* nA = has_next ? (const char*)g.A + (GA ? (size_t)0 : (size_t)nxt.pm * tstep) + nxt.half * hoff : cA; const char* nB = has_next ? (const char*)g.Bt + (g.tile_e ? (size_t)g.tile_e[nxt.pm] * g.estride : (size_t)0) + (size_t)nxt.pn * tstep + nxt.half * hoff : cB;
        for (int t = 0; t < nt; t += 2) {
            if constexpr (Epi::KHOOK) E.khook(t, acc, cur, wr, fr);
            const bool last = (t == nt - 2);
            const char* a1 = cA + (size_t)(t + 1) * kstep;
            const char* a2 = last ? nA : cA + (size_t)(t + 2) * kstep; const char* b2 = last ? nB : cB + (size_t)(t + 2) * kstep;
            const char* a3 = a2 + kstep; const char* b3 = b2 + kstep;
            if (last && has_next) S.a_ready(nxt);
            if constexpr (SP2) {
            unsigned va0[2], va1[2];
            if constexpr (GA) { va0[0] = last ? vn0[0] : vc0[0]; va0[1] = last ? vn0[1] : vc0[1]; va1[0] = last ? vn1[0] : vc1[0]; va1[1] = last ? vn1[1] : vc1[1]; }
            PG8_LDB(B0, 0, 0); PG8_LDB(B1, 0, 1); PG8_SCHED; PG8_LDA(At, 0, 0); if constexpr (GA) PG8_STAGE(PG8_SA(1, 1), a1, vc1); else PG8_STAGE(PG8_SA(1, 1), a1 + hstep, voffA);
            PG8_WAIT_V(8); PG8_WAIT_L(0); PG8_BAR; PG8_MMA(0, 0, At, B0); PG8_MMA(0, 1, At, B1); PG8_BAR; PG8_SCHED;
            PG8_LDA(At, 0, 1); PG8_STAGE(PG8_SB(0, 0), b2, voffB); PG8_STAGE(PG8_SB(0, 1), b2 + hstep, voffB); if constexpr (GA) PG8_STAGE(PG8_SA(0, 0), a2, va0); else PG8_STAGE(PG8_SA(0, 0), a2, voffA);
            PG8_WAIT_V(8); PG8_WAIT_L(0); PG8_BAR; PG8_MMA(1, 0, At, B0); PG8_MMA(1, 1, At, B1); PG8_BAR; PG8_SCHED;
            PG8_LDB(B0, 1, 0); PG8_LDB(B1, 1, 1); PG8_SCHED; PG8_LDA(At, 1, 0); if constexpr (GA) PG8_STAGE(PG8_SA(0, 1), a2, va1); else PG8_STAGE(PG8_SA(0, 1), a2 + hstep, voffA);
            PG8_WAIT_V(8); PG8_WAIT_L(0); PG8_BAR; PG8_MMA(0, 0, At, B0); PG8_MMA(0, 1, At, B1); PG8_BAR; PG8_SCHED;
            PG8_LDA(At, 1, 1); PG8_STAGE(PG8_SB(1, 0), b3, voffB); PG8_STAGE(PG8_SB(1, 1), b3 + hstep, voffB); if constexpr (GA) PG8_STAGE(PG8_SA(1, 0), a3, va0); else PG8_STAGE(PG8_SA(1, 0), a3, voffA);
            PG8_WAIT_V(8); PG8_WAIT_L(0); PG8_BAR; PG8_MMA(1, 0, At, B0); PG8_MMA(1, 1, At, B1); PG8_BAR; PG8_SCHED;
            } else {
            PG8_LDB(B0, 0, 0); PG8_SCHED; PG8_LDA(At, 0, 0); PG8_STAGE(PG8_SA(1, 1), a1 + hstep, voffA);
            PG8_WAIT_L(8); PG8_BAR; PG8_WAIT_L(0); PG8_MMA(0, 0, At, B0); PG8_BAR; PG8_SCHED;
            PG8_LDB(B1, 0, 1); PG8_STAGE(PG8_SB(0, 0), b2, voffB);
            PG8_BAR; PG8_WAIT_L(0); PG8_MMA(0, 1, At, B1); PG8_BAR;
            PG8_LDA(At, 0, 1); PG8_STAGE(PG8_SA(0, 0), a2, voffA);
            PG8_BAR; PG8_WAIT_L(0); PG8_MMA(1, 0, At, B0); PG8_BAR; PG8_SCHED;
            PG8_STAGE(PG8_SB(0, 1), b2 + hstep, voffB);
            PG8_WAIT_V(6); PG8_BAR; PG8_MMA(1, 1, At, B1); PG8_BAR;
            PG8_LDB(B0, 1, 0); PG8_SCHED; PG8_LDA(At, 1, 0); PG8_STAGE(PG8_SA(0, 1), a2 + hstep, voffA);
            PG8_WAIT_L(8); PG8_BAR; PG8_WAIT_L(0); PG8_MMA(0, 0, At, B0); PG8_BAR; PG8_SCHED;
            PG8_LDB(B1, 1, 1); PG8_STAGE(PG8_SB(1, 0), b3, voffB);
            PG8_BAR; PG8_WAIT_L(0); PG8_MMA(0, 1, At, B1); PG8_BAR;
            PG8_LDA(At, 1, 1); PG8_STAGE(PG8_SA(1, 0), a3, voffA);
            PG8_BAR; PG8_WAIT_L(0); PG8_MMA(1, 0, At, B0); PG8_BAR; PG8_SCHED;
            PG8_STAGE(PG8_SB(1, 1), b3 + hstep, voffB);
            PG8_WAIT_V(6); PG8_BAR; PG8_MMA(1, 1, At, B1); PG8_BAR;
            }
        }
        if constexpr (ALIGN_EPI) { if (wr == 0) PG8_BAR; }
        if constexpr (!Epi::AFTER_DRAIN) { E(acc, cur, wr, wc, fr, fq); S.done(cur); }
        if (!has_next) break;
#pragma unroll
        for (int a = 0; a < 2; ++a)
#pragma unroll
            for (int b = 0; b < 2; ++b)
#pragma unroll
                for (int m = 0; m < 4; ++m)
#pragma unroll
                    for (int n = 0; n < 2; ++n) acc[a][b][m][n] = (f32x4){0.f, 0.f, 0.f, 0.f};
        cur = nxt; cA = nA; cB = nB; ++ui;
        if constexpr (GA) { vc0[0] = vn0[0]; vc0[1] = vn0[1]; vc1[0] = vn1[0]; vc1[1] = vn1[1]; }
        if constexpr (ALIGN_EPI) { if (wr == 1) PG8_BAR; }
    }
    PG8_WAIT_V(0);
    if constexpr (!ALIGN_EPI) { if (wr == 0) PG8_BAR; }
    PG8_BAR;
    if constexpr (Epi::AFTER_DRAIN) { E.fused(acc, cur, wr, wc, fr, fq, lds, wid, lane); S.done(cur); }
#undef PG8_SA
#undef PG8_SB
#undef PG8_STAGE
#undef PG8_GOFF
#undef PG8_LDA
#undef PG8_LDB
#undef PG8_MMA
#undef PG8_WAIT_V
#undef PG8_WAIT_L
#undef PG8_BAR
#undef PG8_SCHED
}
}

constexpr int S = 16384, D = 1024, DEPTH = 4, DPROJ = 2560, DFF = 2816, NEXP = 8;
#ifndef PPITCH_V
#define PPITCH_V 2688
#endif
constexpr int PPITCH = PPITCH_V;
constexpr int O_QSB = 0, O_KSB = 256, O_VSB = 512, O_QCA = 768, O_KCA = 1280, O_VCA = 1792, O_U = 2304;
constexpr int NWAVES = 8;
constexpr float LOG2E = 1.4426950408889634f;
constexpr float QSCALE = 0.125f * LOG2E;
constexpr float SB_STOP = -40.f;
#ifndef WGM_INPROJ
#define WGM_INPROJ 4
#endif
#ifndef WGM_GLU
#define WGM_GLU 4
#endif
#ifndef WGM_OUT
#define WGM_OUT 4
#endif
#ifndef WGM_DND
#define WGM_DND 4
#endif
#ifndef WGM_GUD
#define WGM_GUD 4
#endif
#ifndef WGM_GUM
#define WGM_GUM 4
#endif
#ifndef WGM_DNM
#define WGM_DNM 4
#endif
#ifndef FILL_B1
#define FILL_B1 8
#endif
#ifndef FILL_GLU
#define FILL_GLU 4
#endif
#ifndef FILL_MDN2
#define FILL_MDN2 0
#endif
#ifndef FILL_MDN
#define FILL_MDN 20
#endif
#ifndef MK_ONE_LAUNCH
#define MK_ONE_LAUNCH 1
#endif
constexpr bool ONE_LAUNCH = MK_ONE_LAUNCH;
constexpr int PH_PER_LAYER = 11, N_PHASES = 1 + DEPTH * PH_PER_LAYER + 1;

constexpr size_t MiB = 1u << 20;
constexpr size_t WS_CTL = 0, CTL_ZERO_BYTES = 1 * MiB;
constexpr size_t WS_TOKE = 1 * MiB, WS_TOKPOS = WS_TOKE + 128 * 1024, WS_TOKG = WS_TOKPOS + 128 * 1024, WS_TOKSLOT = WS_TOKG + 128 * 1024;
constexpr size_t WS_SEND = 2 * MiB;
constexpr size_t WS_SLOTTOK = 3 * MiB;
constexpr size_t WS_WIN = 4 * MiB, WIN_BYTES = (size_t)DPROJ * D * 2;
constexpr size_t WS_WGLU = 24 * MiB, WGLU_BYTES = 512 * 256 * 2;
constexpr size_t WS_WOUT = 25 * MiB, WOUT_BYTES = (size_t)D * D * 2;
constexpr size_t WS_GU = 33 * MiB, GU_BYTES = (size_t)2 * DFF * D * 2;
constexpr size_t WS_DN = 231 * MiB, DN_BYTES = (size_t)D * DFF * 2;
constexpr size_t WS_H = 330 * MiB;
constexpr size_t WS_R1 = 362 * MiB;
constexpr size_t WS_PROJ = WS_R1, WS_MIXRAW = WS_R1 + 96 * MiB, WS_MIXN = WS_R1 + 128 * MiB, WS_YG = WS_R1 + 160 * MiB;
static_assert((size_t)16384 * PPITCH * 2 <= 96 * MiB, "PROJ fits its slot");
constexpr size_t WS_R2 = 549 * MiB;
constexpr size_t WS_SS = 617 * MiB;
constexpr size_t SS_A = WS_SS, SS_B = WS_SS + 1 * MiB, SSQ_SSM = WS_SS + 2 * MiB, SSQ_SB = SSQ_SSM + 512 * 1024, SSQ_CA = SSQ_SB + 256 * 1024, RSTD_TOK = SSQ_CA + 512 * 1024, SLOT_RS = RSTD_TOK + 64 * 1024, RSTD_A = SLOT_RS + 192 * 1024, RSTD_B = RSTD_A + 64 * 1024;
constexpr size_t WS_TAB = 621 * MiB;
constexpr size_t TAB_A = WS_TAB, TAB_B = WS_TAB + 65536;
constexpr size_t WS_Y2 = 622 * MiB;
constexpr size_t WS_END = 690 * MiB;
constexpr int MAXTILES = 136;
constexpr int CW_SSMF = 8192;
constexpr int CW_BAR = 4096;
constexpr int CW_WGCNT = 20480;
constexpr int CW_MOE = 16384, MOE_WORDS = 1024;

constexpr int WAVE_LDS = 17920;
constexpr int MISC_OFF = 8 * WAVE_LDS;
constexpr int RS_OFF = 131072;
constexpr int LDS_BYTES = 147456;

#define GAS __attribute__((address_space(1)))
#define LAS __attribute__((address_space(3)))
typedef unsigned short bf16;
typedef unsigned v4u __attribute__((ext_vector_type(4)));
typedef unsigned v2u __attribute__((ext_vector_type(2)));
typedef float f32x4 __attribute__((ext_vector_type(4)));
#define LDS_WAIT() asm volatile("s_waitcnt lgkmcnt(0)" ::: "memory")
#define VM_WAIT() asm volatile("s_waitcnt vmcnt(0)" ::: "memory")
__device__ __forceinline__ float bf_lo(unsigned u) { return __builtin_bit_cast(float, u << 16); }
__device__ __forceinline__ float bf_hi(unsigned u) { return __builtin_bit_cast(float, u & 0xffff0000u); }
__device__ __forceinline__ unsigned pk2(float lo, float hi) { return pg8::cvt_pk_bf16(lo, hi); }
__device__ __forceinline__ float wave_sum(float v) {
#pragma unroll
    for (int o = 1; o < 64; o <<= 1) v += __shfl_xor(v, o);
    return v;
}
__device__ __forceinline__ float fexp2(float x) { return __builtin_amdgcn_exp2f(x); }
__device__ __forceinline__ float flog2(float x) { return __builtin_amdgcn_logf(x); }

struct Args { const float* in[27]; float* out; unsigned char* ws; int ph_lo, ph_hi; };

__device__ __forceinline__ void conv_item(const float* __restrict__ W, int K, int N, bf16* __restrict__ WT, int mode, LAS float* scr, int item, int lane, const float* __restrict__ gk = nullptr, bool kperm = false) {
    const int nblk = N / 32, kb = item / nblk, nb = item % nblk, k0 = 64 * kb, n0 = 32 * nb;
    const int c = lane & 7;
    f32x4 g0 = (f32x4){1.f, 1.f, 1.f, 1.f}, g1 = g0;
    if (gk) { g0 = *(const f32x4*)(gk + k0 + 8 * c); g1 = *(const f32x4*)(gk + k0 + 8 * c + 4); }
    float wv[32];
#pragma unroll
    for (int i = 0; i < 32; ++i) wv[i] = W[(size_t)(k0 + 2 * i + (lane >> 5)) * N + n0 + (lane & 31)];
#pragma unroll
    for (int i = 0; i < 32; ++i) scr[(2 * i + (lane >> 5)) * 33 + (lane & 31)] = wv[i];
    LDS_WAIT();
    int r0 = n0;
    if (mode == 1) { const int pn = n0 >> 8, nl = n0 & 255; r0 = 256 * pn + 128 * ((nl >> 5) & 1) + 32 * (nl >> 6); }
    else if (mode == 2) { const int hi = n0 >= 256, nn = n0 & 255; r0 = 256 * (nn >> 7) + 128 * hi + (nn & 127); }
    else if (mode == 3) { r0 = 256 * (n0 >> 7) + (n0 & 127); }
    else if (mode == 4) { r0 = 256 * (n0 >> 7) + 128 + (n0 & 127); }
    const int kd0 = kperm ? (k0 >= 768 ? k0 - 768 : k0 + 256) : k0;
#pragma unroll
    for (int j = 0; j < 4; ++j) { const int n = (lane >> 3) + 8 * j; const LAS float* s = scr + (8 * c) * 33 + n;
        v4u o; o.x = pk2(s[0 * 33] * g0[0], s[1 * 33] * g0[1]); o.y = pk2(s[2 * 33] * g0[2], s[3 * 33] * g0[3]); o.z = pk2(s[4 * 33] * g1[0], s[5 * 33] * g1[1]); o.w = pk2(s[6 * 33] * g1[2], s[7 * 33] * g1[3]);
        *(v4u*)(WT + (size_t)(r0 + n) * K + kd0 + 8 * c) = o; }
    LDS_WAIT();
}
constexpr int IT_IN = (D / 64) * (DPROJ / 32), IT_GLU = (256 / 64) * (512 / 32), IT_OUT = (D / 64) * (D / 32), IT_FF = (D / 64) * (DFF / 32);
static_assert(IT_FF == (DFF / 64) * (D / 32), "gate/up and down have the same item count");
constexpr int IT_B = IT_IN + IT_GLU + IT_OUT, IT_F = 3 * IT_FF, IT_M = NEXP * IT_F;
constexpr int CV_B0 = IT_B, CV_F0 = CV_B0 + IT_F, CV_B1 = CV_F0 + IT_B, CV_M1 = CV_B1 + IT_M, CV_B2 = CV_M1 + IT_B, CV_F1 = CV_B2 + IT_F, CV_B3 = CV_F1 + IT_B, CV_M3 = CV_B3 + IT_M, NIT_TOTAL = CV_M3;
typedef const Args __attribute__((address_space(4)))* CArgsP;
__device__ __forceinline__ void conv_B(CArgsP ap, int l, int r, LAS float* scr, int lane) {
    unsigned char* ws = ap->ws;
    if (r < IT_IN) conv_item(ap->in[2] + (size_t)l * D * DPROJ, D, DPROJ, (bf16*)(ws + WS_WIN + l * WIN_BYTES), 1, scr, r, lane, ap->in[1] + (size_t)l * D);
    else if (r < IT_IN + IT_GLU) conv_item(ap->in[16] + (size_t)l * 256 * 512, 256, 512, (bf16*)(ws + WS_WGLU + l * WGLU_BYTES), 2, scr, r - IT_IN, lane);
    else conv_item(ap->in[18] + (size_t)l * D * D, D, D, (bf16*)(ws + WS_WOUT + l * WOUT_BYTES), 0, scr, r - IT_IN - IT_GLU, lane, ap->in[17] + (size_t)l * D, true);
}
__device__ __forceinline__ void conv_F(CArgsP ap, int f, int r, LAS float* scr, int lane) {
    unsigned char* ws = ap->ws;
    const int which = r / IT_FF, idx = r % IT_FF; const size_t mo = (size_t)(f < 2 ? f : f - 2) * D * DFF;
    const float* gk = ap->in[19] + (size_t)(f < 2 ? 2 * f : (f < 10 ? 1 : 3)) * D;
    if (which == 0) conv_item((f < 2 ? ap->in[20] : ap->in[24]) + mo, D, DFF, (bf16*)(ws + WS_GU + f * GU_BYTES), 3, scr, idx, lane, gk);
    else if (which == 1) conv_item((f < 2 ? ap->in[21] : ap->in[25]) + mo, D, DFF, (bf16*)(ws + WS_GU + f * GU_BYTES), 4, scr, idx, lane, gk);
    else conv_item((f < 2 ? ap->in[22] : ap->in[26]) + mo, DFF, D, (bf16*)(ws + WS_DN + f * DN_BYTES), 0, scr, idx, lane);
}
__device__ __forceinline__ void conv_one(CArgsP ap, int it, LAS float* scr, int lane) {
    int r = it;
    if (r < CV_B0) { conv_B(ap, 0, r, scr, lane); return; } r -= IT_B;
    if (r < IT_F) { conv_F(ap, 0, r, scr, lane); return; } r -= IT_F;
    if (r < IT_B) { conv_B(ap, 1, r, scr, lane); return; } r -= IT_B;
    if (r < IT_M) { conv_F(ap, 2 + r / IT_F, r % IT_F, scr, lane); return; } r -= IT_M;
    if (r < IT_B) { conv_B(ap, 2, r, scr, lane); return; } r -= IT_B;
    if (r < IT_F) { conv_F(ap, 1, r, scr, lane); return; } r -= IT_F;
    if (r < IT_B) { conv_B(ap, 3, r, scr, lane); return; } r -= IT_B;
    conv_F(ap, 10 + r / IT_F, r % IT_F, scr, lane);
}
__device__ __forceinline__ void conv_fill(CArgsP ap, int& cvc, int first_cu, int budget, LAS float* scr, int wave, int lane) {
    const int G = gridDim.x, bx = blockIdx.x, nsw = (G - first_cu) * NWAVES, n = nsw * budget;
    int b = cvc + n; if (b > NIT_TOTAL) b = NIT_TOTAL;
    if (bx >= first_cu) for (int it = cvc + (bx - first_cu) * NWAVES + wave; it < b; it += nsw) conv_one(ap, it, scr, lane);
    cvc = b;
}
__device__ __forceinline__ void conv_drain(CArgsP ap, int& cvc, int required, LAS float* scr, int wave, int lane) {
    if (cvc >= required) return;
    const int nsw = gridDim.x * NWAVES;
    for (int it = cvc + blockIdx.x * NWAVES + wave; it < required; it += nsw) conv_one(ap, it, scr, lane);
    cvc = required;
}

__device__ __forceinline__ void row_phase(const float* __restrict__ xsrc, float* __restrict__ X, bool writeX, const bf16* __restrict__ Y, const bf16* __restrict__ Y2, const int* __restrict__ split, const int* __restrict__ tok_slot, const float* __restrict__ tok_g,
                                          bf16* __restrict__ XB, float* __restrict__ rstd_out, int gw, int NGW, int lane, float oscale = 1.f) {
    for (int row0 = gw; row0 < S; row0 += 2 * NGW) {
        const bool two = row0 + NGW < S;
        f32x4 v[2][4]; int s0[2], s1[2]; float g0[2], g1[2];
#pragma unroll
        for (int j = 0; j < 2; ++j) { const int row = (j == 0 || two) ? row0 + j * NGW : row0;
#pragma unroll
            for (int i = 0; i < 4; ++i) v[j][i] = *(const f32x4*)(xsrc + (size_t)row * D + 4 * lane + 256 * i);
            if (Y) { s0[j] = tok_slot[2 * row]; s1[j] = tok_slot[2 * row + 1]; g0[j] = tok_g[2 * row]; g1[j] = tok_g[2 * row + 1]; } }
        if (Y) {
            v2u a[2][4], b[2][4]; int k0[2], k1[2];
#pragma unroll
            for (int j = 0; j < 2; ++j) {
#pragma unroll
                for (int i = 0; i < 4; ++i) { a[j][i] = *(const v2u*)(Y + (size_t)s0[j] * D + 4 * lane + 256 * i); b[j][i] = *(const v2u*)(Y + (size_t)s1[j] * D + 4 * lane + 256 * i); }
                k0[j] = split[s0[j] >> 8]; k1[j] = split[s1[j] >> 8]; }
#pragma unroll
            for (int j = 0; j < 2; ++j) {
#pragma unroll
                for (int i = 0; i < 4; ++i) { v[j][i][0] += g0[j] * bf_lo(a[j][i].x) + g1[j] * bf_lo(b[j][i].x); v[j][i][1] += g0[j] * bf_hi(a[j][i].x) + g1[j] * bf_hi(b[j][i].x);
                    v[j][i][2] += g0[j] * bf_lo(a[j][i].y) + g1[j] * bf_lo(b[j][i].y); v[j][i][3] += g0[j] * bf_hi(a[j][i].y) + g1[j] * bf_hi(b[j][i].y); }
                if (k0[j] | k1[j]) {
#pragma unroll
                    for (int i = 0; i < 4; ++i) {
                        if ((k0[j] >> i) & 1) { const v2u c = *(const v2u*)(Y2 + (size_t)s0[j] * D + 4 * lane + 256 * i); v[j][i][0] += g0[j] * bf_lo(c.x); v[j][i][1] += g0[j] * bf_hi(c.x); v[j][i][2] += g0[j] * bf_lo(c.y); v[j][i][3] += g0[j] * bf_hi(c.y); }
                        if ((k1[j] >> i) & 1) { const v2u c = *(const v2u*)(Y2 + (size_t)s1[j] * D + 4 * lane + 256 * i); v[j][i][0] += g1[j] * bf_lo(c.x); v[j][i][1] += g1[j] * bf_hi(c.x); v[j][i][2] += g1[j] * bf_lo(c.y); v[j][i][3] += g1[j] * bf_hi(c.y); }
                    }
                }
            }
        }
#pragma unroll
        for (int j = 0; j < 2; ++j) { if (j == 1 && !two) break; const int row = row0 + j * NGW;
            if (writeX) {
#pragma unroll
                for (int i = 0; i < 4; ++i) *(f32x4*)(X + (size_t)row * D + 4 * lane + 256 * i) = v[j][i] * oscale;
            }
            if (!XB) continue;
            float sq = 0.f;
#pragma unroll
            for (int i = 0; i < 4; ++i) { sq += v[j][i][0] * v[j][i][0] + v[j][i][1] * v[j][i][1] + v[j][i][2] * v[j][i][2] + v[j][i][3] * v[j][i][3]; v2u o; o.x = pk2(v[j][i][0], v[j][i][1]); o.y = pk2(v[j][i][2], v[j][i][3]); *(v2u*)(XB + (size_t)row * D + 4 * lane + 256 * i) = o; }
            sq = wave_sum(sq);
            if (lane < 16) rstd_out[(size_t)row * 16 + lane] = (lane == 0) ? sq : 0.f;
        }
    }
}
__device__ __forceinline__ void route_phase(const float* __restrict__ X, const float* __restrict__ gain, const float* __restrict__ Wr, int* __restrict__ wgcnt, float* tok_gw,
                                            int gw, int NGW, int lane, LAS float* wr_s, int tid, int& o_row, int& o_e0, int& o_e1, int& o_p0, int& o_p1, float& o_r) {
    for (int idx = tid; idx < 8192; idx += NWAVES * 64) wr_s[(idx & 7) * 1024 + (idx >> 3)] = Wr[idx];
    if (tid < 128) ((LAS int*)(wr_s + 8192))[tid] = 0;
    __syncthreads();
    LAS int* cnt_s = (LAS int*)(wr_s + 8192); LAS int* loc_s = cnt_s + 128 + (tid >> 6) * 64;
    LAS int* wcnt = cnt_s + 8 * (tid >> 6);
    int krow = 0;
    f32x4 gv[4];
#pragma unroll
    for (int i = 0; i < 4; ++i) gv[i] = *(const f32x4*)(gain + 4 * lane + 256 * i);
    for (int row0 = gw; row0 < S; row0 += 2 * NGW) {
        const bool two = row0 + NGW < S;
        f32x4 v[2][4]; float rr[2];
#pragma unroll
        for (int j = 0; j < 2; ++j) { const int row = (j == 0 || two) ? row0 + j * NGW : row0;
#pragma unroll
            for (int i = 0; i < 4; ++i) v[j][i] = *(const f32x4*)(X + (size_t)row * D + 4 * lane + 256 * i); }
#pragma unroll
        for (int j = 0; j < 2; ++j) { float sq = 0.f;
#pragma unroll
            for (int i = 0; i < 4; ++i) sq += v[j][i][0] * v[j][i][0] + v[j][i][1] * v[j][i][1] + v[j][i][2] * v[j][i][2] + v[j][i][3] * v[j][i][3];
            rr[j] = rsqrtf(wave_sum(sq) * (1.f / D) + 1e-6f);
#pragma unroll
            for (int i = 0; i < 4; ++i) v[j][i] = v[j][i] * rr[j] * gv[i]; }
        float lg[2][8];
#pragma unroll
        for (int e = 0; e < 8; ++e) { lg[0][e] = 0.f; lg[1][e] = 0.f; }
#pragma unroll
        for (int e = 0; e < 8; ++e)
#pragma unroll
            for (int i = 0; i < 4; ++i) { const f32x4 w = *(const LAS f32x4*)(wr_s + e * 1024 + 4 * lane + 256 * i);
#pragma unroll
                for (int j = 0; j < 2; ++j) lg[j][e] += v[j][i][0] * w[0] + v[j][i][1] * w[1] + v[j][i][2] * w[2] + v[j][i][3] * w[3]; }
#pragma unroll
        for (int j = 0; j < 2; ++j)
#pragma unroll
            for (int e = 0; e < 8; ++e) lg[j][e] = wave_sum(lg[j][e]);
        if (lane == 0) {
#pragma unroll
            for (int j = 0; j < 2; ++j) { if (j == 1 && !two) break; const int row = row0 + j * NGW, kk = krow + j;
                int e0 = 0;
#pragma unroll
                for (int e = 1; e < 8; ++e) if (lg[j][e] > lg[j][e0]) e0 = e;
                int e1 = (e0 == 0) ? 1 : 0;
#pragma unroll
                for (int e = 0; e < 8; ++e) if (e != e0 && lg[j][e] > lg[j][e1]) e1 = e;
                asm volatile("" : "+v"(e0), "+v"(e1));
                const float g1 = 1.f / (1.f + __expf(lg[j][e0] - lg[j][e1]));
                tok_gw[2 * row] = 1.f - g1; tok_gw[2 * row + 1] = g1;
                const int r0 = wcnt[e0]; wcnt[e0] = r0 + 1; const int r1 = wcnt[e1]; wcnt[e1] = r1 + 1;
                loc_s[8 * kk] = e0; loc_s[8 * kk + 1] = e1; loc_s[8 * kk + 2] = r0; loc_s[8 * kk + 3] = r1; loc_s[8 * kk + 4] = __float_as_int(rr[j]);
            }
        }
        krow += two ? 2 : 1;
    }
    __syncthreads();
    if (tid < 8) { int run = 0;
#pragma unroll
        for (int w = 0; w < 8; ++w) { cnt_s[64 + 8 * w + tid] = run; run += cnt_s[8 * w + tid]; }
        __hip_atomic_store(wgcnt + blockIdx.x * 8 + tid, run, __ATOMIC_RELAXED, __HIP_MEMORY_SCOPE_AGENT); }
    __syncthreads();
    o_row = -1; o_e0 = 0; o_e1 = 0; o_p0 = 0; o_p1 = 0; o_r = 0.f;
    if (lane < krow) { o_row = gw + lane * NGW; o_e0 = loc_s[8 * lane]; o_e1 = loc_s[8 * lane + 1]; LAS int* pw = cnt_s + 64 + 8 * (tid >> 6);
        o_p0 = pw[o_e0] + loc_s[8 * lane + 2]; o_p1 = pw[o_e1] + loc_s[8 * lane + 3]; o_r = __int_as_float(loc_s[8 * lane + 4]); }
}
__device__ __forceinline__ void perm_phase(int* mctl, const int* __restrict__ wgcnt, int* __restrict__ tok_slot, int* __restrict__ slot_tok, float* __restrict__ slot_rs, LAS int* pre  ,
                                           int gw, int lane, int tid, int row, int e0, int e1, int p0, int p1, float r) {
    __syncthreads();
    if ((int)gridDim.x == 256) {
        const int e = tid >> 6; int c[4];
#pragma unroll
        for (int j = 0; j < 4; ++j) c[j] = wgcnt[(4 * lane + j) * 8 + e];
        const int t4 = (c[0] + c[1]) + (c[2] + c[3]); int incl = t4;
#pragma unroll
        for (int d = 1; d < 64; d <<= 1) { const int o = __shfl_up(incl, d); incl += (lane >= d) ? o : 0; }
        const int ex = incl - t4;
        pre[(4 * lane) * 8 + e] = ex; pre[(4 * lane + 1) * 8 + e] = ex + c[0]; pre[(4 * lane + 2) * 8 + e] = ex + c[0] + c[1]; pre[(4 * lane + 3) * 8 + e] = ex + c[0] + c[1] + c[2];
        if (lane == 63) pre[2048 + e] = incl;
    } else if (tid < 8) { int run = 0; for (int b = 0; b < (int)gridDim.x; ++b) { pre[b * 8 + tid] = run; run += wgcnt[b * 8 + tid]; } pre[2048 + tid] = run; }
    __syncthreads();
    int base[8]; int off = 0;
#pragma unroll
    for (int e = 0; e < 8; ++e) { base[e] = off; off += ((pre[2048 + e] + 255) >> 8) << 8; }
    if (gw == 0) {
        const int nt = off >> 8;
        for (int i = lane; i < nt; i += 64) { int e = 0;
#pragma unroll
            for (int k = 1; k < 8; ++k) e = (i >= (base[k] >> 8)) ? k : e;
            mctl[32 + i] = e; }
        if (lane == 0) mctl[16] = nt;
        const int units = nt * (D / 256);
        if ((int)gridDim.x == 256 && units > 512) { pg8::StaticOrder so; so.init(nt * 256, D, 256, 0, WGM_DNM);
            for (int L = 512 + lane; L < units; L += 64) { pg8::Unit u; so.unit_of(L, u); atomicOr(mctl + 256 + u.pm, 1 << u.pn); } }
    }
    if (row >= 0) {
        int b0 = base[0], b1 = base[0];
#pragma unroll
        for (int k = 1; k < 8; ++k) { b0 = (e0 == k) ? base[k] : b0; b1 = (e1 == k) ? base[k] : b1; }
        const int s0 = b0 + pre[blockIdx.x * 8 + e0] + p0, s1 = b1 + pre[blockIdx.x * 8 + e1] + p1;
        tok_slot[2 * row] = s0; tok_slot[2 * row + 1] = s1; slot_tok[s0] = row; slot_tok[s1] = row; slot_rs[s0] = r; slot_rs[s1] = r;
    }
    if (gw < 8) { const int e = gw; int b = base[0], nb = off;
#pragma unroll
        for (int k = 1; k < 8; ++k) { b = (e == k) ? base[k] : b; }
#pragma unroll
        for (int k = 1; k < 8; ++k) { nb = (e == k - 1) ? base[k] : nb; }
        for (int s = b + pre[2048 + e] + lane; s < nb; s += 64) slot_tok[s] = 0; }
    __syncthreads();
}

struct SsmPar { const float *lam_re, *lam_im, *log_dt, *b_re, *b_im, *c_re, *c_im, *d_skip; };
__device__ __forceinline__ void ssm_coef(const SsmPar& sp, int g, int p, float& are, float& aim, float (&bbr)[16], float (&bbi)[16]) {
    const float dt = expf(sp.log_dt[g]); const float lre = sp.lam_re[g * 64 + p], lim = sp.lam_im[g * 64 + p];
    const float mag = expf(lre * dt), ang = lim * dt; are = mag * cosf(ang); aim = mag * sinf(ang);
    const float nre = are - 1.f, nim = aim, den = lre * lre + lim * lim;
    const float zre = (nre * lre + nim * lim) / den, zim = (nim * lre - nre * lim) / den;
#pragma unroll
    for (int c = 0; c < 16; ++c) { const float br = sp.b_re[(g * 64 + p) * 16 + c], bi = sp.b_im[(g * 64 + p) * 16 + c]; bbr[c] = zre * br - zim * bi; bbi[c] = zre * bi + zim * br; }
}
typedef short sbf16x8 __attribute__((ext_vector_type(8)));

__device__ __forceinline__ void ssm_table_task(const SsmPar& sp, float2* __restrict__ atab, bf16* __restrict__ btab, int lg  , int g, int lane) {
    float are, aim, bbr[16], bbi[16]; ssm_coef(sp, g, lane, are, aim, bbr, bbi);
    atab[(size_t)lg * 64 + lane] = make_float2(are, aim);
    v4u w0, w1, w2, w3;
    w0.x = pk2(bbr[0], bbr[1]); w0.y = pk2(bbr[2], bbr[3]); w0.z = pk2(bbr[4], bbr[5]); w0.w = pk2(bbr[6], bbr[7]);
    w1.x = pk2(bbr[8], bbr[9]); w1.y = pk2(bbr[10], bbr[11]); w1.z = pk2(bbr[12], bbr[13]); w1.w = pk2(bbr[14], bbr[15]);
    w2.x = pk2(bbi[0], bbi[1]); w2.y = pk2(bbi[2], bbi[3]); w2.z = pk2(bbi[4], bbi[5]); w2.w = pk2(bbi[6], bbi[7]);
    w3.x = pk2(bbi[8], bbi[9]); w3.y = pk2(bbi[10], bbi[11]); w3.z = pk2(bbi[12], bbi[13]); w3.w = pk2(bbi[14], bbi[15]);
    v4u* d = (v4u*)(btab + ((size_t)lg * 128 + 2 * lane) * 16);
    d[0] = w0; d[1] = w1; d[2] = w2; d[3] = w3;
}
typedef float f32x16s __attribute__((ext_vector_type(16)));
typedef float f32x2v __attribute__((ext_vector_type(2)));
constexpr int BU_PITCH = 528;
__device__ __forceinline__ void ssm_bu_mfma(f32x16s (&D)[4], const sbf16x8 (&af)[4], const bf16* __restrict__ P, int tok0, int g, int lane) {
    const int r = lane & 31, h = lane >> 5;
    const sbf16x8 bfr = *(const sbf16x8*)(P + (size_t)(tok0 + r) * PPITCH + O_U + g * 16 + 8 * h);
#pragma unroll
    for (int mt = 0; mt < 4; ++mt) { f32x16s z;
#pragma unroll
        for (int i = 0; i < 16; ++i) z[i] = 0.f;
        D[mt] = __builtin_amdgcn_mfma_f32_32x32x16_bf16(af[mt], bfr, z, 0, 0, 0); }
}
__device__ __forceinline__ void ssm_bu_store(const f32x16s (&D)[4], LAS unsigned char* bu, int sub, int lane) {
    const int r = lane & 31, h = lane >> 5;
    if ((r >> 4) == sub) {
#pragma unroll
        for (int mt = 0; mt < 4; ++mt)
#pragma unroll
            for (int g4 = 0; g4 < 4; ++g4) *(LAS f32x4*)(bu + (r & 15) * BU_PITCH + (32 * mt + 8 * g4 + 4 * h) * 4) = (f32x4){D[mt][4 * g4], D[mt][4 * g4 + 1], D[mt][4 * g4 + 2], D[mt][4 * g4 + 3]};
    }
}
__device__ __forceinline__ void ssm_load_af(sbf16x8 (&af)[4], const bf16* __restrict__ btab, int lg, int lane) {
    const int r = lane & 31, h = lane >> 5;
#pragma unroll
    for (int mt = 0; mt < 4; ++mt) af[mt] = *(const sbf16x8*)(btab + ((size_t)lg * 128 + 32 * mt + r) * 16 + 8 * h);
}
__device__ __forceinline__ void ssm_a2_task(const bf16* __restrict__ P, const float2* __restrict__ atab, const bf16* __restrict__ btab, float2* __restrict__ Send, LAS unsigned char* wl, int lg, int g, int cp, int lane) {
    const float2 a = atab[(size_t)lg * 64 + lane]; const float are = a.x, aim = a.y;
    sbf16x8 af[4]; ssm_load_af(af, btab, lg, lane);
    float xr = 0.f, xi = 0.f;
    for (int nt = 0; nt < 4; ++nt) {
        f32x16s Dt[4]; ssm_bu_mfma(Dt, af, P, cp * 128 + 32 * nt, g, lane);
#pragma unroll
        for (int sub = 0; sub < 2; ++sub) {
            LDS_WAIT();
            ssm_bu_store(Dt, wl, sub, lane);
            LDS_WAIT();
#pragma unroll 4
            for (int s = 0; s < 16; ++s) { const f32x2v b = *(const LAS f32x2v*)(wl + s * BU_PITCH + lane * 8); const float nr = are * xr - aim * xi + b.x, ni = are * xi + aim * xr + b.y; xr = nr; xi = ni; }
        }
    }
    __hip_atomic_store((unsigned long long*)(Send + ((size_t)g * 128 + cp) * 64 + lane), ((unsigned long long)__float_as_uint(xi) << 32) | (unsigned long long)__float_as_uint(xr), __ATOMIC_RELAXED, __HIP_MEMORY_SCOPE_AGENT);
}
__device__ __forceinline__ void ssm_c2_task(const bf16* __restrict__ P, const SsmPar& sp, const float2* __restrict__ atab, const bf16* __restrict__ btab, const float2* __restrict__ Send, bf16* __restrict__ YG,
                                            LAS unsigned char* wl, int lg, int g, int cp, int lane) {
    const float2 a = atab[(size_t)lg * 64 + lane]; const float are = a.x, aim = a.y;
    sbf16x8 af[4]; ssm_load_af(af, btab, lg, lane);
    LAS unsigned char* bu = wl;
    LAS unsigned char* xs = wl + 8448;
    const int fr = lane & 15, fq = lane >> 4;
    sbf16x8 cf[4];
#pragma unroll
    for (int kk = 0; kk < 4; ++kk) {
        const f32x4 cr = *(const f32x4*)(sp.c_re + (size_t)(g * 16 + fr) * 64 + 16 * kk + 4 * fq), ci = *(const f32x4*)(sp.c_im + (size_t)(g * 16 + fr) * 64 + 16 * kk + 4 * fq);
        v4u w; w.x = pk2(cr[0], -ci[0]); w.y = pk2(cr[1], -ci[1]); w.z = pk2(cr[2], -ci[2]); w.w = pk2(cr[3], -ci[3]);
        cf[kk] = __builtin_bit_cast(sbf16x8, w);
    }
    const f32x4 dsk = *(const f32x4*)(sp.d_skip + g * 16 + 4 * fq);
    float pr = are, pi = aim;
#pragma unroll
    for (int i = 0; i < 7; ++i) { const float nr = pr * pr - pi * pi, ni = 2.f * pr * pi; pr = nr; pi = ni; }
    float xr = 0.f, xi = 0.f;
    {
        const float2* sp0 = Send + (size_t)g * 128 * 64 + lane; const int nc = cp; int c = 0;
        for (; c + 64 <= nc; c += 64) { float2 s[64];
#pragma unroll
            for (int j = 0; j < 64; ++j) s[j] = sp0[(size_t)(c + j) * 64];
#pragma unroll
            for (int j = 0; j < 64; ++j) { const float nr = pr * xr - pi * xi + s[j].x, ni = pr * xi + pi * xr + s[j].y; xr = nr; xi = ni; } }
        for (; c + 32 <= nc; c += 32) { float2 s[32];
#pragma unroll
            for (int j = 0; j < 32; ++j) s[j] = sp0[(size_t)(c + j) * 64];
#pragma unroll
            for (int j = 0; j < 32; ++j) { const float nr = pr * xr - pi * xi + s[j].x, ni = pr * xi + pi * xr + s[j].y; xr = nr; xi = ni; } }
        for (; c + 8 <= nc; c += 8) { float2 s[8];
#pragma unroll
            for (int j = 0; j < 8; ++j) s[j] = sp0[(size_t)(c + j) * 64];
#pragma unroll
            for (int j = 0; j < 8; ++j) { const float nr = pr * xr - pi * xi + s[j].x, ni = pr * xi + pi * xr + s[j].y; xr = nr; xi = ni; } }
        for (; c < nc; ++c) { const float2 s = sp0[(size_t)c * 64]; const float nr = pr * xr - pi * xi + s.x, ni = pr * xi + pi * xr + s.y; xr = nr; xi = ni; }
    }
    for (int q = 0; q < 4; ++q) {
        const int tok0 = cp * 128 + 32 * q;
        f32x16s Dt[4]; ssm_bu_mfma(Dt, af, P, tok0, g, lane);
#pragma unroll
        for (int sub = 0; sub < 2; ++sub) {
            LDS_WAIT();
            ssm_bu_store(Dt, bu, sub, lane);
            LDS_WAIT();
#pragma unroll 4
            for (int s = 0; s < 16; ++s) { const f32x2v b = *(const LAS f32x2v*)(bu + s * BU_PITCH + lane * 8); const float nr = are * xr - aim * xi + b.x, ni = are * xi + aim * xr + b.y; xr = nr; xi = ni;
                *(LAS unsigned*)(xs + s * 272 + lane * 4) = pk2(xr, xi); }
            LDS_WAIT();
            f32x4 acc = (f32x4){0.f, 0.f, 0.f, 0.f};
#pragma unroll
            for (int kk = 0; kk < 4; ++kk) { const sbf16x8 xf = *(const LAS sbf16x8*)(xs + fr * 272 + 64 * kk + 16 * fq); acc = __builtin_amdgcn_mfma_f32_16x16x32_bf16(cf[kk], xf, acc, 0, 0, 0); }
            const int tok = tok0 + 16 * sub + fr;
            const v2u ub = *(const v2u*)(P + (size_t)tok * PPITCH + O_U + g * 16 + 4 * fq);
            const float u0 = bf_lo(ub.x), u1 = bf_hi(ub.x), u2 = bf_lo(ub.y), u3 = bf_hi(ub.y);
            float o[4]; const float uu[4] = {u0, u1, u2, u3};
#pragma unroll
            for (int e = 0; e < 4; ++e) { const float y = acc[e] + dsk[e] * uu[e]; const float u2 = 1.5957691216057308f * (y + 0.044715f * y * y * y); o[e] = y * __builtin_amdgcn_rcpf(1.f + __expf(-u2)); }
            v2u w; w.x = pk2(o[0], o[1]); w.y = pk2(o[2], o[3]);
            __hip_atomic_store((unsigned long long*)(YG + (size_t)tok * 256 + g * 16 + 4 * fq), ((unsigned long long)w.y << 32) | (unsigned long long)w.x, __ATOMIC_RELAXED, __HIP_MEMORY_SCOPE_AGENT);
        }
    }
}


typedef short bf16x8 __attribute__((ext_vector_type(8)));
typedef short s16x4 __attribute__((ext_vector_type(4)));
typedef short v4i16_t __attribute__((ext_vector_type(4)));
typedef float f32x16 __attribute__((ext_vector_type(16)));
typedef float f32x2_t __attribute__((ext_vector_type(2))); typedef __bf16 bf16x2_t __attribute__((ext_vector_type(2)));
#define MFMA32(a, b, c) __builtin_amdgcn_mfma_f32_32x32x16_bf16((a), (b), (c), 0, 0, 0)
__device__ __forceinline__ unsigned cvtpk_s(float lo, float hi) { f32x2_t v = {lo, hi}; bf16x2_t b = __builtin_convertvector(v, bf16x2_t); return __builtin_bit_cast(unsigned, b); }
__device__ __forceinline__ s16x4 vtr(const LAS unsigned char* p) { return __builtin_bit_cast(s16x4, __builtin_amdgcn_ds_read_tr16_b64_v4i16((LAS v4i16_t*)p)); }
__device__ __forceinline__ bf16x8 pack_step(const f32x16& x, int s) {
    v4u p; p.x = cvtpk_s(x[8 * s], x[8 * s + 1]); p.y = cvtpk_s(x[8 * s + 2], x[8 * s + 3]); p.z = cvtpk_s(x[8 * s + 4], x[8 * s + 5]); p.w = cvtpk_s(x[8 * s + 6], x[8 * s + 7]);
    return __builtin_bit_cast(bf16x8, p);
}
__device__ __forceinline__ void load_kfrags(bf16x8 (&kf)[2][4], const bf16* __restrict__ kbase  , int r, int h) {
#pragma unroll
    for (int kb = 0; kb < 2; ++kb)
#pragma unroll
        for (int st = 0; st < 4; ++st) kf[kb][st] = *(const bf16x8*)(kbase + (size_t)(32 * kb + r) * PPITCH + 16 * st + 8 * h);
}
__device__ __forceinline__ void load_vregs(v4u (&vr)[8], const bf16* __restrict__ vbase, int lane) {
#pragma unroll
    for (int i = 0; i < 8; ++i) vr[i] = *(const v4u*)(vbase + (size_t)(i * 8 + (lane >> 3)) * PPITCH + (lane & 7) * 8);
}
__device__ __forceinline__ void store_vtile(const v4u (&vr)[8], LAS unsigned char* vt, int lane) {
    const int c = lane & 7;
#pragma unroll
    for (int i = 0; i < 8; ++i) *(LAS v4u*)(vt + (c >> 2) * 4096 + (i * 8 + (lane >> 3)) * 64 + (c & 3) * 16) = vr[i];
}
__device__ __forceinline__ void qk_tile(f32x16 (&x)[2], const bf16x8 (&kf)[2][4], const bf16x8 (&qf)[4]) {
#pragma unroll
    for (int kb = 0; kb < 2; ++kb) {
        f32x16 a;
#pragma unroll
        for (int i = 0; i < 16; ++i) a[i] = 0.f;
#pragma unroll
        for (int st = 0; st < 4; ++st) a = MFMA32(kf[kb][st], qf[st], a);
        x[kb] = a;
    }
}
__device__ __forceinline__ void pv_tile(f32x16 (&oT)[2], const f32x16 (&p)[2], const LAS unsigned char* vt, int lane) {
    const int i16 = lane & 15, q = i16 >> 2, pp = i16 & 3, blk = (lane >> 4) & 1, h = lane >> 5;
    const LAS unsigned char* vb = vt + (4 * h + q) * 64 + 8 * (4 * blk + pp);
#pragma unroll
    for (int kb = 0; kb < 2; ++kb)
#pragma unroll
        for (int s = 0; s < 2; ++s) {
            const bf16x8 xs = pack_step(p[kb], s);
#pragma unroll
            for (int dt = 0; dt < 2; ++dt) {
                const s16x4 lo = vtr(vb + dt * 4096 + (32 * kb + 16 * s) * 64), hi = vtr(vb + dt * 4096 + (32 * kb + 16 * s + 8) * 64);
                const bf16x8 pa = __builtin_shufflevector(lo, hi, 0, 1, 2, 3, 4, 5, 6, 7);
                oT[dt] = MFMA32(pa, xs, oT[dt]);
            }
        }
}
__device__ __forceinline__ void store_oT(const f32x16 (&oT)[2], float sc, bf16* __restrict__ orow  , int h, float* __restrict__ ssq_row  ) {
    float sq = 0.f;
#pragma unroll
    for (int dt = 0; dt < 2; ++dt)
#pragma unroll
        for (int g = 0; g < 4; ++g) { const float a = oT[dt][4 * g] * sc, b = oT[dt][4 * g + 1] * sc, c = oT[dt][4 * g + 2] * sc, d = oT[dt][4 * g + 3] * sc; sq += a * a + b * b + c * c + d * d;
            v2u w; w.x = cvtpk_s(a, b); w.y = cvtpk_s(c, d);
            *(v2u*)(orow + 32 * dt + 8 * g + 4 * h) = w; }
    sq += __shfl_xor(sq, 32);
    if (h == 0) *ssq_row = sq;
}

__device__ __forceinline__ void sb_task_mfma(const bf16* __restrict__ P, bf16* __restrict__ MIXRAW, float* __restrict__ ssq, LAS unsigned char* wl, int head, int q0, int lane) {
    const int r = lane & 31, h = lane >> 5;
    bf16x8 qf[4];
#pragma unroll
    for (int st = 0; st < 4; ++st) qf[st] = *(const bf16x8*)(P + (size_t)(q0 + r) * PPITCH + O_QSB + head * 64 + 16 * st + 8 * h);
    f32x16 oT[2];
#pragma unroll
    for (int i = 0; i < 16; ++i) { oT[0][i] = 0.f; oT[1][i] = 0.f; }
    float carry = 0.f;
    const int kt0 = q0 >> 6;
    for (int kt = kt0; kt >= 0; --kt) {
        bf16x8 kf[2][4]; v4u vr[8];
        load_kfrags(kf, P + (size_t)kt * 64 * PPITCH + O_KSB + head * 64, r, h);
        load_vregs(vr, P + (size_t)kt * 64 * PPITCH + O_VSB + head * 64, lane);
        f32x16 x[2];
        qk_tile(x, kf, qf);
        LDS_WAIT();
        store_vtile(vr, wl, lane);
        const bool diag = (kt == kt0);
        f32x16 ln[2];
#pragma unroll
        for (int kb = 0; kb < 2; ++kb)
#pragma unroll
            for (int i = 0; i < 16; ++i) {
                const float z = x[kb][i];
                float l = -(fmaxf(z, 0.f) + flog2(1.f + fexp2(-fabsf(z))));
                if (diag) { const int kpos = kt * 64 + 32 * kb + (i & 3) + 8 * (i >> 2) + 4 * h; l = (kpos < q0 + r) ? l : 0.f; }
                ln[kb][i] = l;
            }
        float Tm[8], Tp[8], suf[2][16];
#pragma unroll
        for (int kb = 0; kb < 2; ++kb)
#pragma unroll
            for (int g = 0; g < 4; ++g) {
                const float e0 = ln[kb][4 * g], e1 = ln[kb][4 * g + 1], e2 = ln[kb][4 * g + 2], e3 = ln[kb][4 * g + 3];
                suf[kb][4 * g + 3] = 0.f; suf[kb][4 * g + 2] = e3; suf[kb][4 * g + 1] = e3 + e2; suf[kb][4 * g] = e3 + e2 + e1;
                Tm[4 * kb + g] = (e3 + e2) + (e1 + e0);
            }
#pragma unroll
        for (int i = 0; i < 8; ++i) Tp[i] = __shfl_xor(Tm[i], 32);
        float R[8]; R[7] = 0.f;
#pragma unroll
        for (int i = 6; i >= 0; --i) R[i] = R[i + 1] + (Tm[i + 1] + Tp[i + 1]);
        const float tile_total = R[0] + (Tm[0] + Tp[0]);
        f32x16 w[2];
#pragma unroll
        for (int kb = 0; kb < 2; ++kb)
#pragma unroll
            for (int g = 0; g < 4; ++g) {
                const int gi = 4 * kb + g;
                const float off = carry + R[gi] + (h ? 0.f : Tp[gi]);
#pragma unroll
                for (int e = 0; e < 4; ++e) {
                    const int i = 4 * g + e;
                    float ww = fexp2(x[kb][i] + ln[kb][i] + (off + suf[kb][i]));
                    if (diag) { const int kpos = kt * 64 + 32 * kb + e + 8 * g + 4 * h; ww = (kpos < q0 + r) ? ww : 0.f; }
                    w[kb][i] = ww;
                }
            }
        carry += tile_total;
        pv_tile(oT, w, wl, lane);
        if (__all(carry < SB_STOP)) break;
    }
    store_oT(oT, 1.f, MIXRAW + (size_t)(q0 + r) * D + 256 + head * 64, h, ssq + (size_t)(q0 + r) * 4 + head);
}

__device__ __forceinline__ void ca_unit(const bf16* __restrict__ P, const float* __restrict__ rel_bias, bf16* __restrict__ MIXRAW, float* __restrict__ ssq, LAS unsigned char* sh, int head, int c0, int wave, int lane, int tid) {
    const int r = lane & 31, h = lane >> 5, ci = c0 + (wave >> 1), q0 = 64 * ci + 32 * (wave & 1);
    LAS unsigned char* Ks = sh; LAS unsigned char* Vs = sh + 16384; LAS float* bias_s = (LAS float*)(sh + 32768);
    __syncthreads();
    for (int i = tid; i < 320; i += NWAVES * 64) bias_s[i] = rel_bias[head * 257 + (i < 256 ? i : 256)] * LOG2E;
    bf16x8 qf[4];
#pragma unroll
    for (int st = 0; st < 4; ++st) qf[st] = *(const bf16x8*)(P + (size_t)(q0 + r) * PPITCH + O_QCA + head * 64 + 16 * st + 8 * h);
    f32x16 oT[2];
#pragma unroll
    for (int i = 0; i < 16; ++i) { oT[0][i] = 0.f; oT[1][i] = 0.f; }
    float m = -1e30f, l = 0.f;
    const int t0 = (c0 >= 8 ? c0 - 8 : 0), t1 = c0 + 3;
    const int srow = tid >> 3, sc = tid & 7;
    const int koff = srow * 128 + ((sc ^ (srow & 7)) << 4), voff = (sc >> 2) * 4096 + srow * 64 + (sc & 3) * 16;
    v4u kreg = *(const v4u*)(P + (size_t)(t0 * 64 + srow) * PPITCH + O_KCA + head * 64 + sc * 8);
    v4u vreg = *(const v4u*)(P + (size_t)(t0 * 64 + srow) * PPITCH + O_VCA + head * 64 + sc * 8);
    *(LAS v4u*)(Ks + koff) = kreg; *(LAS v4u*)(Vs + voff) = vreg;
    __syncthreads();
    const float bfar = bias_s[256];
    for (int t = t0; t <= t1; ++t) {
        const int cur = (t - t0) & 1;
        if (t < t1) { kreg = *(const v4u*)(P + (size_t)((t + 1) * 64 + srow) * PPITCH + O_KCA + head * 64 + sc * 8); vreg = *(const v4u*)(P + (size_t)((t + 1) * 64 + srow) * PPITCH + O_VCA + head * 64 + sc * 8); }
        if (t <= ci && t + 8 >= ci) {
            const LAS unsigned char* kb_ = Ks + cur * 8192;
            bf16x8 kf[2][4];
#pragma unroll
            for (int kb = 0; kb < 2; ++kb)
#pragma unroll
                for (int st = 0; st < 4; ++st) { const int row = 32 * kb + r; kf[kb][st] = *(const LAS bf16x8*)(kb_ + row * 128 + (((2 * st + h) ^ (row & 7)) << 4)); }
            f32x16 x[2];
            qk_tile(x, kf, qf);
            float badd = bfar;
            if (ci - t < 3) { badd = 0.f;
                const LAS float* bp = bias_s + ((q0 + r) - t * 64 - 4 * h + 128);
#pragma unroll
                for (int kb = 0; kb < 2; ++kb)
#pragma unroll
                    for (int i = 0; i < 16; ++i) x[kb][i] += bp[-(32 * kb + (i & 3) + 8 * (i >> 2))];
            }
            float tm = x[0][0];
#pragma unroll
            for (int kb = 0; kb < 2; ++kb)
#pragma unroll
                for (int i = 0; i < 16; ++i) tm = fmaxf(tm, x[kb][i]);
            tm = fmaxf(tm, __shfl_xor(tm, 32)) + badd;
            if (__any(tm > m)) {
                const float mn = fmaxf(m, tm), scl = fexp2(m - mn); m = mn; l *= scl;
#pragma unroll
                for (int i = 0; i < 16; ++i) { oT[0][i] *= scl; oT[1][i] *= scl; }
            }
            const float mm = m - badd; const f32x2v mm2 = {mm, mm}; f32x2v ps2 = {0.f, 0.f};
#pragma unroll
            for (int kb = 0; kb < 2; ++kb)
#pragma unroll
                for (int i = 0; i < 16; i += 2) { f32x2v v = {x[kb][i], x[kb][i + 1]}; v = v - mm2; f32x2v p; p.x = fexp2(v.x); p.y = fexp2(v.y); x[kb][i] = p.x; x[kb][i + 1] = p.y; ps2 = ps2 + p; }
            l += ps2.x + ps2.y;
            pv_tile(oT, x, Vs + cur * 8192, lane);
        }
        if (t < t1) { *(LAS v4u*)(Ks + (cur ^ 1) * 8192 + koff) = kreg; *(LAS v4u*)(Vs + (cur ^ 1) * 8192 + voff) = vreg; }
        __syncthreads();
    }
    l += __shfl_xor(l, 32);
    store_oT(oT, 1.f / l, MIXRAW + (size_t)(q0 + r) * D + 512 + head * 64, h, ssq + (size_t)(q0 + r) * 8 + head);
}
#define XB_TMO      128
#define XB_XCNT(j)  (256  + 64 * (j))
#define XB_XSUB(j)  (1280 + 64 * (j))
#define XB_XGEN(j)  (2304 + 64 * (j))
#define XB_TOP      3328
#define XB_TOPGEN   3392
#define XCD_BAR_WORDS 3456
#define XB_SPIN_CAP (1u << 18)

__device__ __forceinline__ unsigned xb_ld(unsigned* p)              { return __hip_atomic_load(p, __ATOMIC_RELAXED, __HIP_MEMORY_SCOPE_AGENT); }
__device__ __forceinline__ unsigned xb_add(unsigned* p, unsigned v) { return __hip_atomic_fetch_add(p, v, __ATOMIC_RELAXED, __HIP_MEMORY_SCOPE_AGENT); }
__device__ __forceinline__ unsigned xb_xcc_id() { return (unsigned)__builtin_amdgcn_s_getreg((3 << 11) | 20) & 0xFu; }
#define XB_SPIN(cond, bar) do { unsigned _sp = 0; while (cond) { __builtin_amdgcn_s_sleep(1); \
    if ((++_sp & 255u) == 0u) { if (xb_ld(&(bar)[XB_TMO])) break; if (_sp > XB_SPIN_CAP) { atomicAdd(&(bar)[XB_TMO], 1u); break; } } } } while (0)

struct XcdBarrier {
    int wv;
    unsigned* bar; unsigned x;
    volatile LAS unsigned* st;
};

__device__ __forceinline__ XcdBarrier xcd_barrier_post(unsigned* bar, volatile LAS unsigned* st) {
    XcdBarrier b; b.bar = bar; b.x = xb_xcc_id(); b.st = st;
    if (threadIdx.x == 0) (void)xb_add(&bar[XB_XCNT(b.x)], 1u);
    return b;
}
__device__ __forceinline__ void xcd_barrier_complete(unsigned* bar, unsigned x, unsigned& nloc, unsigned& nx) {
    const unsigned G = gridDim.x * gridDim.y * gridDim.z;
    unsigned sum, cnt, mine, sp = 0u;
    for (;;) {
        sum = 0u; cnt = 0u; mine = 0u;
#pragma unroll
        for (unsigned j = 0; j < 16; ++j) { const unsigned c = xb_ld(&bar[XB_XCNT(j)]); sum += c; cnt += (c > 0u) ? 1u : 0u; mine = (j == x) ? c : mine; }
        if (sum == G) break;
        __builtin_amdgcn_s_sleep(1);
        if ((++sp & 255u) == 0u) { if (xb_ld(&bar[XB_TMO])) break; if (sp > XB_SPIN_CAP) { atomicAdd(&bar[XB_TMO], 1u); break; } }
    }
    nloc = mine > 0u ? mine : 1u; nx = cnt > 0u ? cnt : 1u;
}

__device__ __forceinline__ void xcd_barrier(const XcdBarrier& b) {
    asm volatile("s_waitcnt vmcnt(0)" ::: "memory");
    __syncthreads();
    if (b.wv == 0 && __builtin_amdgcn_mbcnt_hi(~0u, __builtin_amdgcn_mbcnt_lo(~0u, 0u)) == 0u) {
        unsigned* bar = b.bar;
        __builtin_amdgcn_s_waitcnt(0);
        unsigned nloc = b.st[0], nx = b.st[1];
        if (nloc == 0u) { xcd_barrier_complete(bar, b.x, nloc, nx); b.st[0] = nloc; b.st[1] = nx; }
        const unsigned old = xb_add(&bar[XB_XSUB(b.x)], 1u);
        const unsigned gen = old / nloc;
        if (old + 1u == (gen + 1u) * nloc) {
            __builtin_amdgcn_fence(__ATOMIC_RELEASE, "agent");
            asm volatile("s_waitcnt vmcnt(0)" ::: "memory");
            const unsigned og = xb_add(&bar[XB_TOP], 1u);
            const unsigned tg = og / nx;
            if (og + 1u == (tg + 1u) * nx) xb_add(&bar[XB_TOPGEN], 1u);
            else XB_SPIN(xb_ld(&bar[XB_TOPGEN]) == tg, bar);
            __builtin_amdgcn_fence(__ATOMIC_ACQUIRE, "agent");
            xb_add(&bar[XB_XGEN(b.x)], 1u);
            asm volatile("s_waitcnt vmcnt(0)" ::: "memory");
        } else {
            XB_SPIN(xb_ld(&bar[XB_XGEN(b.x)]) == gen, bar);
            __builtin_amdgcn_fence(__ATOMIC_ACQUIRE, "agent");
            asm volatile("s_waitcnt vmcnt(0)" ::: "memory");
        }
    }
    __syncthreads();
}

typedef const Args __attribute__((address_space(4)))* CArgs;
#define LARGS() ({ CArgs p_ = (CArgs)__builtin_amdgcn_kernarg_segment_ptr(); asm volatile("" : "+s"(p_)); p_; })
#define LINT(x) ({ int v_ = (x); asm volatile("" : "+s"(v_)); v_; })

#define PH_BEGIN(kind)
#define PH_END(kind)
#define SEAM() do { if (ONE_LAUNCH) { XcdBarrier b_ = bar; asm volatile("" : "+s"(b_.bar)); xcd_barrier(b_); } } while (0)
#define IN(k) ({ CArgs a_ = LARGS(); const int k_ = (k); a_->ph_lo <= k_ && k_ < a_->ph_hi; })
#define PTID() ({ int t_; asm volatile("v_mbcnt_lo_u32_b32 %0, -1, 0\n\tv_mbcnt_hi_u32_b32 %0, -1, %0" : "=v"(t_)); wave_s * 64 + t_; })
#define FILL_SHORT(units, budget) do { const int u_ = (units) % (int)gridDim.x; if (u_ != 0) { WAVE_IDS(); conv_fill(LARGS(), cvc, u_, (budget), (LAS float*)wl, wave, lane); } } while (0)
#define DRAIN(req) do { conv_drain(LARGS(), cvc, (req), (LAS float*)wl, wave, lane); } while (0)
#define RS_PREPASS(So, ss16) do { const int tid_ = PTID(); LAS float* rt_ = (LAS float*)(lds + RS_OFF); \
    for (int i_ = 0; i_ < 12; ++i_) { const long L_ = (long)i_ * (So).G + (So).c; if (L_ >= (So).nwg) break; pg8::Unit u_; (So).unit_of((int)L_, u_); \
        if (tid_ < 256) { const float* p_ = (ss16) + ((size_t)u_.pm * 256 + tid_) * 16; rt_[i_ * 256 + tid_] = rsqrtf(pg8::sum16f(p_) * (1.f / D) + 1e-6f); } } \
    __syncthreads(); } while (0)
#define WAVE_IDS() const int tid = PTID(), lane = tid & 63, wave = wave_s; const int G = gridDim.x, bx = blockIdx.x; const int gw = bx * NWAVES + wave, NGW = G * NWAVES; LAS unsigned char* wl = lds + wave * WAVE_LDS; (void)wl; (void)gw; (void)NGW; (void)lane; (void)G; (void)bx

template <int lraw> __device__ __forceinline__ void layer_body(LAS unsigned char* lds, const XcdBarrier& bar, const int wave_s, int& cvc) {
    constexpr bool MOE = (lraw & 1) != 0;
    constexpr int CVB_NEXT = lraw == 0 ? CV_B1 : (lraw == 1 ? CV_B2 : (lraw == 2 ? CV_B3 : CV_M3));
    if (!MOE) if (IN(1 + lraw * PH_PER_LAYER + 0)) { PH_BEGIN(1);
        WAVE_IDS(); CArgs A = LARGS(); unsigned char* ws = A->ws;
        row_phase(lraw == 0 ? A->in[0] : A->out, A->out, lraw != 0, lraw == 0 ? nullptr : (const bf16*)(ws + WS_R2), (const bf16*)(ws + WS_Y2), (const int*)(ws + WS_CTL) + CW_MOE + 0 * MOE_WORDS + 256, (const int*)(ws + WS_TOKSLOT), (const float*)(ws + WS_TOKG), (bf16*)(ws + WS_H), (float*)(ws + SS_A), gw, NGW, lane);
        DRAIN(lraw == 0 ? CV_B0 : CV_B2);
        SEAM(); PH_END(1);
    }
    if (IN(1 + lraw * PH_PER_LAYER + 1)) { PH_BEGIN(2);
        CArgs A = LARGS(); const int l = LINT(lraw); unsigned char* ws = A->ws;
        pg8::Gemm g{(const bf16*)(ws + WS_H), (const bf16*)(ws + WS_WIN + l * WIN_BYTES), S, DPROJ, D, nullptr, 0, PTID()}; pg8::StaticOrder So; So.init(S, DPROJ, gridDim.x, blockIdx.x, WGM_INPROJ);
        pg8::EpiInProj E{(bf16*)(ws + WS_PROJ), A->in[3] + l * 64, A->in[4] + l * 64, A->in[5] + l * 64, A->in[6] + l * 64, QSCALE, (const LAS float*)(lds + RS_OFF), PPITCH};
        RS_PREPASS(So, (const float*)(ws + SS_A));
        pg8::gemm_phase<pg8::EpiInProj, pg8::StaticOrder, true, true>(lds, g, So, E);
        FILL_SHORT((S / 256) * (DPROJ / 256), FILL_B1);
        SEAM(); PH_END(2);
    }
    if (IN(1 + lraw * PH_PER_LAYER + 2)) { PH_BEGIN(3);
        WAVE_IDS(); CArgs A = LARGS(); const int l = LINT(lraw); unsigned char* ws = A->ws;
        const bf16* PROJ = (const bf16*)(ws + WS_PROJ); bf16* MIXRAW = (bf16*)(ws + WS_MIXRAW);
        SsmPar sp{A->in[8] + l * 1024, A->in[9] + l * 1024, A->in[10] + l * 16, A->in[11] + (size_t)l * 16384, A->in[12] + (size_t)l * 16384, A->in[13] + (size_t)l * 16384, A->in[14] + (size_t)l * 16384, A->in[15] + l * 256};
        unsigned* flag = (unsigned*)(ws + WS_CTL) + CW_SSMF + 64 * l;
        for (int t = gw; t < 2048; t += NGW) ssm_a2_task(PROJ, (const float2*)(ws + TAB_A), (const bf16*)(ws + TAB_B), (float2*)(ws + WS_SEND), wl, l * 16 + (t & 15), t & 15, t >> 4, lane);
        asm volatile("s_waitcnt vmcnt(0)" ::: "memory");
        __syncthreads();
        if (wave == 0 && lane == 0) xb_add(flag, 1u);
        for (int t = gw; t < 2048; t += NGW) sb_task_mfma(PROJ, MIXRAW, (float*)(ws + SSQ_SB), wl, t & 3, 32 * (t >> 2), lane);
        __syncthreads();
        if (G == 256) { const int v = bx >> 3; ca_unit(PROJ, A->in[7] + (size_t)l * 8 * 257, MIXRAW, (float*)(ws + SSQ_CA), lds, v & 7, 32 * (bx & 7) + 4 * (v >> 3), wave, lane, tid); }
        __syncthreads();
        { unsigned sp_ = 0; while (xb_ld(flag) < (unsigned)G) { __builtin_amdgcn_s_sleep(2); if (++sp_ > (1u << 22)) break; } }
        asm volatile("" ::: "memory");
        for (int t = gw; t < 2048; t += NGW) ssm_c2_task(PROJ, sp, (const float2*)(ws + TAB_A), (const bf16*)(ws + TAB_B), (const float2*)(ws + WS_SEND), (bf16*)(ws + WS_YG), wl, l * 16 + (t & 15), t & 15, t >> 4, lane);
        asm volatile("s_waitcnt vmcnt(0)" ::: "memory");
        __syncthreads();
        if (wave == 0 && lane == 0) xb_add(flag + 32, 1u);
        if (G == 256) { const int v = 32 + (bx >> 3); ca_unit(PROJ, A->in[7] + (size_t)l * 8 * 257, MIXRAW, (float*)(ws + SSQ_CA), lds, v & 7, 32 * (bx & 7) + 4 * (v >> 3), wave, lane, tid); }
        __syncthreads();
        { unsigned sp_ = 0; while (xb_ld(flag + 32) < (unsigned)G) { __builtin_amdgcn_s_sleep(2); if (++sp_ > (1u << 22)) break; } }
        asm volatile("" ::: "memory");
        { CArgs A2 = LARGS(); unsigned char* ws2 = A2->ws;
          pg8::Gemm g{(const bf16*)(ws2 + WS_YG), (const bf16*)(ws2 + WS_WGLU + l * WGLU_BYTES), S, 512, 256, nullptr, 0, PTID()}; pg8::StaticOrder So; So.init(S, 512, gridDim.x, blockIdx.x, WGM_GLU);
          pg8::EpiGated<0> E{(bf16*)(ws2 + WS_MIXRAW), D, 0, nullptr, (float*)(ws2 + SSQ_SSM), nullptr};
          pg8::gemm_phase<pg8::EpiGated<0>, pg8::StaticOrder, true, true>(lds, g, So, E); }
        FILL_SHORT((S / 256) * 2, FILL_GLU);
        SEAM(); PH_END(3);
    }
    if (IN(1 + lraw * PH_PER_LAYER + 6)) { PH_BEGIN(7);
        CArgs A = LARGS(); const int l = LINT(lraw); unsigned char* ws = A->ws;
        pg8::Gemm g{(const bf16*)(ws + WS_MIXRAW), (const bf16*)(ws + WS_WOUT + l * WOUT_BYTES), S, D, D, nullptr, 0, PTID()}; pg8::StaticOrder So; So.init(S, D, gridDim.x, blockIdx.x, WGM_OUT);
        LAS float* fac = (LAS float*)(lds + MISC_OFF + 256);
        { pg8::Unit u0; const int tid = PTID(); if (So.first_unit(u0) && tid < 256) {
              const size_t row = (size_t)u0.pm * 256 + tid;
              const float rs = rsqrtf(pg8::sum8f((const float*)(ws + SSQ_SSM) + row * 8) * (1.f / 256.f) + 1e-6f), rb = rsqrtf(pg8::sum4f((const float*)(ws + SSQ_SB) + row * 4) * (1.f / 256.f) + 1e-6f),
                          rc = rsqrtf(pg8::sum8f((const float*)(ws + SSQ_CA) + row * 8) * (1.f / 512.f) + 1e-6f);
              fac[tid] = rs / rb; fac[256 + tid] = rb / rc; fac[512 + tid] = rc; }
          __syncthreads(); }
        pg8::EpiResidual<true> E{A->out, lraw == 0 ? A->in[0] : A->out, D, 1.f, (bf16*)(ws + WS_H), (float*)(ws + SS_B), fac};
        pg8::gemm_phase<pg8::EpiResidual<true>, pg8::StaticOrder, true, true>(lds, g, So, E);
        if (!MOE) { WAVE_IDS(); DRAIN(lraw == 0 ? CV_F0 : CV_F1); }
        SEAM(); PH_END(7);
    }
    if (!MOE) {
        if (IN(1 + lraw * PH_PER_LAYER + 8)) { PH_BEGIN(10);
            CArgs A = LARGS(); const int l = LINT(lraw); unsigned char* ws = A->ws; const int fidx = l >> 1;
            pg8::Gemm g{(const bf16*)(ws + WS_H), (const bf16*)(ws + WS_GU + fidx * GU_BYTES), S, 2 * DFF, D, nullptr, 0, PTID()}; pg8::StaticOrder So; So.init(S, 2 * DFF, gridDim.x, blockIdx.x, WGM_GUD);
            pg8::EpiGated<1, 2> E{(bf16*)(ws + WS_R1), DFF, 0, nullptr, nullptr, (const LAS float*)(lds + RS_OFF)};
            RS_PREPASS(So, (const float*)(ws + SS_B));
            pg8::gemm_phase<pg8::EpiGated<1, 2>, pg8::StaticOrder, true, true>(lds, g, So, E);
            FILL_SHORT((S / 256) * (2 * DFF / 256), FILL_B1);
            SEAM(); PH_END(10);
        }
        if (IN(1 + lraw * PH_PER_LAYER + 9)) { PH_BEGIN(11);
            CArgs A = LARGS(); const int l = LINT(lraw); unsigned char* ws = A->ws; const int fidx = l >> 1;
            pg8::Gemm g{(const bf16*)(ws + WS_R1), (const bf16*)(ws + WS_DN + fidx * DN_BYTES), S, D, DFF, nullptr, 0, PTID()}; pg8::StaticOrder So; So.init(S, D, gridDim.x, blockIdx.x, WGM_DND);
            pg8::EpiResidual<false> E{A->out, A->out, D, 1.f, (bf16*)(ws + WS_H), (float*)(ws + SS_A), nullptr};
            pg8::gemm_phase<pg8::EpiResidual<false>, pg8::StaticOrder, true, true>(lds, g, So, E);
            { WAVE_IDS(); DRAIN(CVB_NEXT); }
            SEAM(); PH_END(11);
        }
    } else {
        if (IN(1 + lraw * PH_PER_LAYER + 7)) { PH_BEGIN(9);
            WAVE_IDS(); CArgs A = LARGS(); const int l = LINT(lraw); unsigned char* ws = A->ws;
            int r_row, r_e0, r_e1, r_p0, r_p1; float r_r;
            route_phase(A->out, A->in[19] + (size_t)l * D, A->in[23] + (size_t)(l >> 1) * D * 8, (int*)(ws + WS_CTL) + CW_WGCNT, (float*)(ws + WS_TOKG), gw, NGW, lane, (LAS float*)lds, tid, r_row, r_e0, r_e1, r_p0, r_p1, r_r);
            unsigned* flag = (unsigned*)(ws + WS_CTL) + CW_SSMF + 64 * l + 16;
            asm volatile("s_waitcnt vmcnt(0)" ::: "memory");
            __syncthreads();
            if (wave == 0 && lane == 0) xb_add(flag, 1u);
            DRAIN(lraw == 1 ? CV_M1 : CV_M3);
            { unsigned sp_ = 0; while (xb_ld(flag) < (unsigned)G) { __builtin_amdgcn_s_sleep(2); if (++sp_ > (1u << 22)) break; } }
            asm volatile("" ::: "memory");
            { CArgs A2 = LARGS(); unsigned char* ws2 = A2->ws;
              perm_phase((int*)(ws2 + WS_CTL) + CW_MOE + (l >> 1) * MOE_WORDS, (const int*)(ws2 + WS_CTL) + CW_WGCNT, (int*)(ws2 + WS_TOKSLOT), (int*)(ws2 + WS_SLOTTOK), (float*)(ws2 + SLOT_RS), (LAS int*)lds, gw, lane, tid, r_row, r_e0, r_e1, r_p0, r_p1, r_r); }
            SEAM(); PH_END(9);
        }
        if (IN(1 + lraw * PH_PER_LAYER + 9)) { PH_BEGIN(13);
            CArgs A = LARGS(); const int l = LINT(lraw); unsigned char* ws = A->ws; const int fidx = 2 + NEXP * (l >> 1);
            const int* mctl = (const int*)(ws + WS_CTL) + CW_MOE + (l >> 1) * MOE_WORDS; const int nt = mctl[16];
            pg8::Gemm g{(const bf16*)(ws + WS_H), (const bf16*)(ws + WS_GU + fidx * GU_BYTES), nt * 256, 2 * DFF, D, mctl + 32, GU_BYTES, PTID(), 0, (const int*)(ws + WS_SLOTTOK)}; pg8::StaticOrder So; So.init(nt * 256, 2 * DFF, gridDim.x, blockIdx.x, WGM_GUM);
            pg8::EpiGated<1, 1> E{(bf16*)(ws + WS_R1), DFF, 0, (const float*)(ws + SLOT_RS), nullptr, nullptr};
            pg8::gemm_phase<pg8::EpiGated<1, 1>, pg8::StaticOrder, true, true>(lds, g, So, E);
            FILL_SHORT(nt * (2 * DFF / 256), FILL_B1);
            SEAM(); PH_END(13);
        }
        if (IN(1 + lraw * PH_PER_LAYER + 10)) { PH_BEGIN(14);
            CArgs A = LARGS(); const int l = LINT(lraw); unsigned char* ws = A->ws; const int fidx = 2 + NEXP * (l >> 1);
            const int* mctl = (const int*)(ws + WS_CTL) + CW_MOE + (l >> 1) * MOE_WORDS; const int nt = mctl[16];
            pg8::Gemm g{(const bf16*)(ws + WS_R1), (const bf16*)(ws + WS_DN + fidx * DN_BYTES), nt * 256, D, DFF, mctl + 32, DN_BYTES, PTID()}; pg8::StaticOrder So; So.init(nt * 256, D, gridDim.x, blockIdx.x, WGM_DNM);
            pg8::EpiStoreBf16 E{(bf16*)(ws + WS_R2), D, (bf16*)(ws + WS_Y2)};
            const int units = nt * (D / 256);
            if (gridDim.x == 256 && units > 512) {
                So.limit = 512;
                pg8::gemm_phase<pg8::EpiStoreBf16, pg8::StaticOrder, true, true>(lds, g, So, E);
                pg8::LeftoverOrder Lo; Lo.init(nt * 256, D, gridDim.x, blockIdx.x, 512, WGM_DNM); pg8::Gemm g2 = g; g2.Klen = DFF / 2; g2.tid = PTID();
                pg8::gemm_phase<pg8::EpiStoreBf16, pg8::LeftoverOrder, true, true>(lds, g2, Lo, E);
                if (lraw == 1) { FILL_SHORT(2 * (units - 512) < 256 ? 2 * (units - 512) : 0, FILL_MDN2); }
            } else {
                pg8::gemm_phase<pg8::EpiStoreBf16, pg8::StaticOrder, true, true>(lds, g, So, E);
                if (lraw == 1) { FILL_SHORT(units, FILL_MDN); }
            }
            if (lraw == 1) { WAVE_IDS(); DRAIN(CVB_NEXT); }
            SEAM(); PH_END(14);
        }
    }
}

__global__ void __launch_bounds__(NWAVES * 64, 2) mk_fwd(Args args_unused) {
    extern __shared__ __attribute__((aligned(16))) unsigned char lds_raw[];
    LAS unsigned char* lds = (LAS unsigned char*)lds_raw;
    volatile LAS unsigned* MISC = (volatile LAS unsigned*)(lds + MISC_OFF);
    if (threadIdx.x < 32) MISC[threadIdx.x] = 0u;
    __syncthreads();
    const int wave_s = __builtin_amdgcn_readfirstlane(threadIdx.x >> 6);
    XcdBarrier bar; { CArgs A = LARGS(); bar.bar = (unsigned*)(A->ws + WS_CTL) + CW_BAR; bar.x = 0; bar.st = nullptr; if (ONE_LAUNCH) bar = xcd_barrier_post((unsigned*)(A->ws + WS_CTL) + CW_BAR, MISC + 8); bar.wv = wave_s; }
    int cvc = 0;
    if (IN(0)) { PH_BEGIN(0); WAVE_IDS(); CArgs A = LARGS(); conv_drain(A, cvc, CV_B0, (LAS float*)wl, wave, lane);
        if (gw < 64) { const int l = gw >> 4, g = gw & 15; unsigned char* ws = A->ws;
            SsmPar sp{A->in[8] + l * 1024, A->in[9] + l * 1024, A->in[10] + l * 16, A->in[11] + (size_t)l * 16384, A->in[12] + (size_t)l * 16384, A->in[13] + (size_t)l * 16384, A->in[14] + (size_t)l * 16384, A->in[15] + l * 256};
            ssm_table_task(sp, (float2*)(ws + TAB_A), (bf16*)(ws + TAB_B), gw, g, lane); } PH_END(0); }

    layer_body<0>(lds, bar, wave_s, cvc); layer_body<1>(lds, bar, wave_s, cvc); layer_body<2>(lds, bar, wave_s, cvc); layer_body<3>(lds, bar, wave_s, cvc);
    if (IN(N_PHASES - 1)) { WAVE_IDS(); CArgs A = LARGS(); unsigned char* ws = A->ws;
        row_phase(A->out, A->out, true, (const bf16*)(ws + WS_R2), (const bf16*)(ws + WS_Y2), (const int*)(ws + WS_CTL) + CW_MOE + 1 * MOE_WORDS + 256, (const int*)(ws + WS_TOKSLOT), (const float*)(ws + WS_TOKG), nullptr, nullptr, gw, NGW, lane); }
#undef IN
#undef SEAM
}

extern "C" void kernel_launch(void* const* d_in, const int* in_sizes, int n_in, void* d_out, int out_size, void* d_ws, size_t ws_size, hipStream_t stream) {
    static int grid = 0;
    if (grid == 0) {
        if (n_in != 27 || out_size != S * D || ws_size < WS_END) { fprintf(stderr, "kernel_launch: unexpected problem (n_in %d, out %d, ws %zu)\n", n_in, out_size, ws_size); grid = -1; return; }
        int dev = 0, cus = 0, per_cu = 0;
        if (hipGetDevice(&dev) != hipSuccess || hipDeviceGetAttribute(&cus, hipDeviceAttributeMultiprocessorCount, dev) != hipSuccess) { grid = -1; return; }
        if (hipFuncSetAttribute((const void*)mk_fwd, hipFuncAttributeMaxDynamicSharedMemorySize, LDS_BYTES) != hipSuccess) { fprintf(stderr, "kernel_launch: hipFuncSetAttribute failed\n"); grid = -1; return; }
        if (hipOccupancyMaxActiveBlocksPerMultiprocessor(&per_cu, (const void*)mk_fwd, NWAVES * 64, LDS_BYTES) != hipSuccess || per_cu < 1) { fprintf(stderr, "kernel_launch: occupancy query says %d\n", per_cu); }
        (void)hipGetLastError();
        if (cus < 256 || per_cu < 1) { fprintf(stderr, "kernel_launch: needs 256 CUs with one resident 512-thread workgroup each (have %d CUs, %d per CU)\n", cus, per_cu); grid = -1; return; }
        grid = 256;
    }
    if (grid < 0) return;
    if (hipMemsetAsync((char*)d_ws + WS_CTL, 0, CTL_ZERO_BYTES, stream) != hipSuccess) return;
    Args a{};
    for (int i = 0; i < 27; ++i) a.in[i] = (const float*)d_in[i];
    a.out = (float*)d_out; a.ws = (unsigned char*)d_ws;
    if (ONE_LAUNCH) {
        a.ph_lo = 0; a.ph_hi = N_PHASES;
        hipLaunchKernelGGL(mk_fwd, dim3(grid), dim3(NWAVES * 64), LDS_BYTES, stream, a);
    } else {
        for (int p = 0; p < N_PHASES; ++p) {
            if (p >= 1 && p < N_PHASES - 1) { const int l = (p - 1) / PH_PER_LAYER, k = (p - 1) % PH_PER_LAYER; const bool moe = l & 1;
                if (k == 5 || (k == 0 && moe) || (k == 7 && !moe) || (k == 10 && !moe)) continue; }
            a.ph_lo = p; a.ph_hi = p + 1;
            hipLaunchKernelGGL(mk_fwd, dim3(grid), dim3(NWAVES * 64), LDS_BYTES, stream, a);
        }
    }
}
```
